# Optimizing an MI355X kernel written in HIP

```python
import math
import jax, jax.numpy as jnp
from jax import lax
import numpy as np

D_MODEL = 2048
BATCH = 2
SEQ = 4096
DEPTH = 1

CHUNK = 64
N_MEM = 256
EPS = 1e-6
NEG = -1e30

MLA_HEADS = 8
MLA_NOPE = 128
MLA_ROPE = 64
MLA_V = 128
MLA_QLORA = 512
MLA_KVLORA = 256
MLA_WIDTH = MLA_HEADS * MLA_V
ROPE_THETA = 10000.0
QUERY_BLOCK = 128

SWA_HEADS = 8
SWA_KV_HEADS = 2
SWA_HEAD_DIM = 64
SWA_WIDTH = SWA_HEADS * SWA_HEAD_DIM
SWA_KV_WIDTH = SWA_KV_HEADS * SWA_HEAD_DIM
WINDOW = 128
WINDOW_CHUNKS = WINDOW // CHUNK
SWA_BLOCK = 128

MEM_HEADS = 4
MEM_HEAD_DIM = 128
MEM_WIDTH = MEM_HEADS * MEM_HEAD_DIM

MIX_WIDTH = MLA_WIDTH + SWA_WIDTH + MEM_WIDTH

N_BUCKETS = 32
MAX_DISTANCE = 128

IN_SIZES = (
    MLA_QLORA,
    MLA_KVLORA,
    MLA_ROPE,
    MLA_WIDTH,
    SWA_WIDTH,
    SWA_KV_WIDTH,
    SWA_KV_WIDTH,
    SWA_WIDTH,
    MEM_WIDTH,
    MEM_WIDTH,
)
IN_WIDTH = 4160

kernel_name = "hybrid_mla_swa_sink_memory_block"


def rms_norm(x, g):
    xf = x.astype(jnp.float32)
    y = xf * lax.rsqrt(jnp.mean(xf * xf, axis=-1, keepdims=True) + EPS)
    return (y * g.astype(jnp.float32)).astype(x.dtype)


def split_cols(t, sizes):
    idx = []
    acc = 0
    for s in sizes[:-1]:
        acc += s
        idx.append(acc)
    return jnp.split(t, idx, axis=-1)


def rope_tables(seq, dim):
    inv = 1.0 / (ROPE_THETA ** (jnp.arange(0, dim, 2, dtype=jnp.float32) / dim))
    ang = jnp.arange(seq, dtype=jnp.float32)[:, None] * inv[None, :]
    return jnp.cos(ang), jnp.sin(ang)


def apply_rope(x, cos, sin):
    half = x.shape[-1] // 2
    x1 = x[..., :half].astype(jnp.float32)
    x2 = x[..., half:].astype(jnp.float32)
    out = jnp.concatenate([x1 * cos - x2 * sin, x2 * cos + x1 * sin], axis=-1)
    return out.astype(x.dtype)


def t5_bucket(rel):
    nb = N_BUCKETS // 2
    max_exact = nb // 2
    bucket = jnp.where(rel > 0, nb, 0)
    n = jnp.abs(rel)
    nf = jnp.maximum(n, 1).astype(jnp.float32)
    large = max_exact + (jnp.log(nf / max_exact) / math.log(MAX_DISTANCE / max_exact)
                         * (nb - max_exact)).astype(jnp.int32)
    large = jnp.minimum(large, nb - 1)
    return bucket + jnp.where(n < max_exact, n, large)


def mla_attention(c_q, c_kv, k_pe_in, g_q, g_kv, w_uq, w_ukv, cos, sin):
    B, S, _ = c_q.shape
    q = (rms_norm(c_q, g_q) @ w_uq).reshape(B, S, MLA_HEADS, MLA_NOPE + MLA_ROPE)
    q_nope, q_pe = q[..., :MLA_NOPE], q[..., MLA_NOPE:]
    q_pe = apply_rope(q_pe, cos[:, None, :], sin[:, None, :])
    kv = (rms_norm(c_kv, g_kv) @ w_ukv).reshape(B, S, MLA_HEADS, MLA_NOPE + MLA_V)
    k_nope, v = kv[..., :MLA_NOPE], kv[..., MLA_NOPE:]
    k_pe = apply_rope(k_pe_in, cos, sin)
    scale = (MLA_NOPE + MLA_ROPE) ** -0.5
    nblk = S // QUERY_BLOCK
    qn_b = q_nope.reshape(B, nblk, QUERY_BLOCK, MLA_HEADS, MLA_NOPE).transpose(1, 0, 2, 3, 4)
    qp_b = q_pe.reshape(B, nblk, QUERY_BLOCK, MLA_HEADS, MLA_ROPE).transpose(1, 0, 2, 3, 4)
    k_chunk = jnp.arange(S) // CHUNK

    def block(args):
        qn, qp, b = args
        q_chunk = (b * QUERY_BLOCK + jnp.arange(QUERY_BLOCK)) // CHUNK
        s = (jnp.einsum('bqhd,bkhd->bhqk', qn, k_nope)
             + jnp.einsum('bqhd,bkd->bhqk', qp, k_pe)).astype(jnp.float32) * scale
        mask = k_chunk[None, :] <= q_chunk[:, None]
        s = jnp.where(mask[None, None], s, NEG)
        p = jax.nn.softmax(s, axis=-1).astype(v.dtype)
        return jnp.einsum('bhqk,bkhd->bqhd', p, v)

    out = lax.map(block, (qn_b, qp_b, jnp.arange(nblk)))
    return out.transpose(1, 0, 2, 3, 4).reshape(B, S, MLA_WIDTH)


def swa_attention(q, k, v, sinks, rel_table):
    B, S, _ = q.shape
    nblk = S // SWA_BLOCK
    G = SWA_HEADS // SWA_KV_HEADS
    q = q.reshape(B, nblk, SWA_BLOCK, SWA_KV_HEADS, G, SWA_HEAD_DIM)

    def band(t):
        t = t.reshape(B, S, SWA_KV_HEADS, SWA_HEAD_DIM)
        t = jnp.pad(t, ((0, 0), (SWA_BLOCK, 0), (0, 0), (0, 0)))
        t = t.reshape(B, nblk + 1, SWA_BLOCK, SWA_KV_HEADS, SWA_HEAD_DIM)
        return jnp.concatenate([t[:, :-1], t[:, 1:]], axis=2)

    k_band, v_band = band(k), band(v)
    s = jnp.einsum('bnqkgd,bnjkd->bnkgqj', q, k_band).astype(jnp.float32) * (SWA_HEAD_DIM ** -0.5)
    qi = jnp.arange(SWA_BLOCK)
    kj = jnp.arange(2 * SWA_BLOCK)
    rel = kj[None, :] - SWA_BLOCK - qi[:, None]
    bias = rel_table.astype(jnp.float32)[t5_bucket(rel)]
    bias = bias.transpose(2, 0, 1).reshape(SWA_KV_HEADS, G, SWA_BLOCK, 2 * SWA_BLOCK)
    s = s + bias
    blk = jnp.arange(nblk)[:, None, None]
    q_pos = blk * SWA_BLOCK + qi[None, :, None]
    k_pos = (blk - 1) * SWA_BLOCK + kj[None, None, :]
    q_c = q_pos // CHUNK
    k_c = k_pos // CHUNK
    valid = (k_pos >= 0) & (k_c <= q_c) & (k_c >= q_c - WINDOW_CHUNKS)
    s = jnp.where(valid[None, :, None, None], s, NEG)
    sink = sinks.astype(jnp.float32).reshape(SWA_KV_HEADS, G)[None, None, :, :, None, None]
    m = jnp.maximum(jnp.max(s, axis=-1, keepdims=True), sink)
    p = jnp.exp(s - m)
    p = p / (jnp.sum(p, axis=-1, keepdims=True) + jnp.exp(sink - m))
    o = jnp.einsum('bnkgqj,bnjkd->bnqkgd', p.astype(v_band.dtype), v_band)
    return o.reshape(B, S, SWA_WIDTH)


def memory_attention(q, mem_n, w_mem_kv):
    B, S, _ = q.shape
    M = mem_n.shape[1]
    kv = mem_n @ w_mem_kv
    k = kv[..., :MEM_WIDTH].reshape(B, M, MEM_HEADS, MEM_HEAD_DIM)
    v = kv[..., MEM_WIDTH:].reshape(B, M, MEM_HEADS, MEM_HEAD_DIM)
    q = q.reshape(B, S, MEM_HEADS, MEM_HEAD_DIM)
    s = jnp.einsum('bshd,bmhd->bhsm', q, k).astype(jnp.float32) * (MEM_HEAD_DIM ** -0.5)
    p = jax.nn.softmax(s, axis=-1).astype(v.dtype)
    return jnp.einsum('bhsm,bmhd->bshd', p, v).reshape(B, S, MEM_WIDTH)


def hybrid_layer(x, mem, g_in, w_in, g_q, g_kv, w_uq, w_ukv, sinks, rel_table,
                 g_mem, w_mem_kv, w_out, cos, sin):
    h = rms_norm(x, g_in)
    (c_q, c_kv, k_pe, z_mla, q_swa, k_swa, v_swa, z_swa, q_mem, z_mem) = split_cols(h @ w_in, IN_SIZES)
    y_mla = mla_attention(c_q, c_kv, k_pe, g_q, g_kv, w_uq, w_ukv, cos, sin) * jax.nn.silu(z_mla)
    y_swa = swa_attention(q_swa, k_swa, v_swa, sinks, rel_table) * jax.nn.silu(z_swa)
    y_mem = memory_attention(q_mem, rms_norm(mem, g_mem), w_mem_kv) * jax.nn.silu(z_mem)
    y = jnp.concatenate([y_mla, y_swa, y_mem], axis=-1) @ w_out
    return x + y


def setup_inputs(seed: int = 0) -> dict:
    key = jax.random.key(seed)
    ks = jax.random.split(key, 16)
    f32 = jnp.float32

    def nrm(k, shape, scale):
        return jax.random.normal(k, shape, f32) * scale

    def gain(k, shape):
        return 1.0 + 0.05 * jax.random.normal(k, shape, f32)

    return {
        "x": jax.random.normal(ks[0], (BATCH, SEQ, D_MODEL), f32),
        "mem": jax.random.normal(ks[1], (BATCH, N_MEM, D_MODEL), f32),
        "norm_in": gain(ks[2], (DEPTH, D_MODEL)),
        "w_in": nrm(ks[3], (DEPTH, D_MODEL, IN_WIDTH), D_MODEL ** -0.5),
        "norm_q": gain(ks[4], (DEPTH, MLA_QLORA)),
        "norm_kv": gain(ks[5], (DEPTH, MLA_KVLORA)),
        "w_uq": nrm(ks[6], (DEPTH, MLA_QLORA, MLA_HEADS * (MLA_NOPE + MLA_ROPE)), MLA_QLORA ** -0.5),
        "w_ukv": nrm(ks[7], (DEPTH, MLA_KVLORA, MLA_HEADS * (MLA_NOPE + MLA_V)), MLA_KVLORA ** -0.5),
        "attn_sinks": nrm(ks[8], (DEPTH, SWA_HEADS), 0.5),
        "rel_bias": nrm(ks[9], (N_BUCKETS, SWA_HEADS), 0.5),
        "norm_mem": gain(ks[10], (DEPTH, D_MODEL)),
        "w_mem_kv": nrm(ks[11], (DEPTH, D_MODEL, 2 * MEM_WIDTH), D_MODEL ** -0.5),
        "w_out": nrm(ks[12], (DEPTH, MIX_WIDTH, D_MODEL), MIX_WIDTH ** -0.5),
        "norm_final": gain(ks[13], (D_MODEL,)),
    }


def reference(x, mem, norm_in, w_in, norm_q, norm_kv, w_uq, w_ukv, attn_sinks, rel_bias,
              norm_mem, w_mem_kv, w_out, norm_final):
    cos, sin = rope_tables(x.shape[1], MLA_ROPE)
    h = x
    for l in range(DEPTH):
        h = hybrid_layer(h, mem, norm_in[l], w_in[l], norm_q[l], norm_kv[l], w_uq[l], w_ukv[l],
                         attn_sinks[l], rel_bias, norm_mem[l], w_mem_kv[l], w_out[l], cos, sin)
    return rms_norm(h, norm_final)
```

```cpp
#include <hip/hip_runtime.h>
#include <hip/hip_bf16.h>
#include <cstdio>
#include <cstdint>

#ifndef PHASE_MASK
#define PHASE_MASK 0xFF
#endif

#ifndef MLA_SD
#define MLA_SD 1
#endif
#define LAS __attribute__((address_space(3)))
#define GAS __attribute__((address_space(1)))
typedef unsigned short bf16_t;
typedef short bf16x8 __attribute__((ext_vector_type(8)));
typedef short s16x4 __attribute__((ext_vector_type(4)));
typedef short v4i16_t __attribute__((ext_vector_type(4)));
typedef float f32x2 __attribute__((ext_vector_type(2)));
typedef float f32x4 __attribute__((ext_vector_type(4)));
typedef float f32x16 __attribute__((ext_vector_type(16)));
typedef unsigned u32x2 __attribute__((ext_vector_type(2)));
typedef unsigned u32x4 __attribute__((ext_vector_type(4)));
typedef GAS unsigned gu32;

constexpr int BATCH = 2, SEQ = 4096, DM = 2048, M = BATCH * SEQ;
constexpr int NMEM = 256, MMEM = BATCH * NMEM;
constexpr int NIN = 4160, NPROJ = 4352;
constexpr int QL = 512, KVL = 256;
constexpr int NQ = 1536, NKV = 2048;
constexpr int NMKV = 1024;
constexpr float EPS = 1e-6f;
constexpr float LOG2E = 1.4426950408889634f;
constexpr int PC_CQ = 0, PC_CKV = 512, PC_ZMLA = 768, PC_QSWA = 1792, PC_KSWA = 2304, PC_VSWA = 2432, PC_ZSWA = 2560, PC_QMEM = 3072, PC_ZMEM = 3584, PC_KPE = 4096;

constexpr size_t MiB = 1u << 20;
constexpr size_t WS_CTL = 0, CTL_ZERO_BYTES = 1 * MiB;
constexpr size_t WS_SSQ = 1 * MiB, WS_SSKV = WS_SSQ + 256 * 1024, WS_SSOUT = 2 * MiB, WS_ROPE = 3 * MiB, WS_BIAS = 4 * MiB;
constexpr size_t WS_WIN = 5 * MiB, WS_WUQ = 22 * MiB, WS_WUKV = 24 * MiB, WS_WMEM = 25 * MiB, WS_WOUT = 29 * MiB;
constexpr size_t WS_MEMN = 37 * MiB, WS_MEMKV = 39 * MiB, WS_H = 40 * MiB, WS_PROJ = 72 * MiB, WS_Q = 140 * MiB, WS_KV = 164 * MiB, WS_MIX = 196 * MiB, WS_END = 228 * MiB;
constexpr int CW_BAR = 4096;

constexpr int RING_BYTES = 131072;
constexpr int LDSCTL_OFF = RING_BYTES, MISC_OFF = LDSCTL_OFF + 320;
constexpr int AT_WS_OFF = RING_BYTES + 1024;
constexpr int AT_BIAS_OFF = AT_WS_OFF + 2048;
constexpr int AT_ML_OFF = AT_BIAS_OFF + 1024;
constexpr int LDS_BYTES = 147456;
constexpr int NWAVES = 8;

#define RLX_AGENT __ATOMIC_RELAXED, __HIP_MEMORY_SCOPE_AGENT
#define LDS_WAIT() asm volatile("s_waitcnt lgkmcnt(0)" ::: "memory")
#define VM_WAIT() asm volatile("s_waitcnt vmcnt(0)" ::: "memory")

__device__ __forceinline__ unsigned cvt_pk_bf16(float lo, float hi) { unsigned r; asm volatile("v_cvt_pk_bf16_f32 %0, %1, %2" : "=v"(r) : "v"(lo), "v"(hi)); return r; }
__device__ __forceinline__ float bf2f(unsigned short b) { return __builtin_bit_cast(float, (unsigned)b << 16); }
__device__ __forceinline__ float wave_sum(float v) {
#pragma unroll
    for (int o = 1; o < 64; o <<= 1) v += __shfl_xor(v, o);
    return v;
}

namespace pg8 {
constexpr int BM = 256, BK = 64, HALF = 128, HTB = HALF * BK * 2, STAGE_BYTES = 8 * HTB, NXCD = 8, WGM = 8;
__host__ __device__ __forceinline__ int lds_byte(int r, int c) { const int st = (r >> 4) * 2 + (c >> 5), rr = r & 15, cc = c & 31, ob = rr * 64 + cc * 2; return st * 1024 + (ob ^ (((ob >> 9) & 1) << 5)); }
__host__ __device__ __forceinline__ void stage_rc(int b, int& R, int& C) { const int st = b / 1024, sb = b % 1024, swz = sb ^ (((sb >> 9) & 1) << 5); R = (st >> 1) * 16 + swz / 64; C = (st & 1) * 32 + (swz % 64) / 2; }
__host__ __device__ __forceinline__ int perm32(int rho) { const int n = rho >> 4, i = rho & 15; return 8 * (i >> 2) + 4 * n + (i & 3); }

struct Unit { int pm, pn; };
struct Gemm { const bf16_t* A; const bf16_t* Bt; int M, N, K, lda, ldb; };

struct StaticOrder {
    int nM, nN, nwg, G, c;
    __device__ void init(int M_, int N_, int G_, int c_) { nM = M_ / BM; nN = N_ / BM; nwg = nM * nN; G = G_; c = c_; }
    __device__ bool next(int i, Unit& u) const {
        const long L = (long)i * G + c; if (L >= nwg) return false;
        int wgid = (int)L; { const int q = nwg / NXCD, r = nwg % NXCD, xcd = wgid % NXCD, off = wgid / NXCD; wgid = (xcd < r ? xcd * (q + 1) : r * (q + 1) + (xcd - r) * q) + off; }
        const int nig = WGM * nN, gid = wgid / nig, fm = gid * WGM, gsz = (nM - fm) < WGM ? (nM - fm) : WGM;
        u.pm = fm + ((wgid % nig) % gsz); u.pn = (wgid % nig) / gsz; return true;
    }
};

template <class Epi>
__device__ __forceinline__ void gemm_phase(LAS unsigned char* lds, const Gemm g, const StaticOrder& S, const Epi& E) {
    int tid = threadIdx.x; asm volatile("" : "+v"(tid));
    const int wid = __builtin_amdgcn_readfirstlane(tid >> 6), lane = tid & 63, wr = wid >> 2, wc = wid & 3, fr = lane & 15, fq = lane >> 4;
    const int K = g.K, nt = K / BK;
    unsigned voffA[2], voffB[2];
#pragma unroll
    for (int i = 0; i < 2; ++i) { int R, C; stage_rc(tid * 16 + i * 8192, R, C); const int Rb = Epi::PERM ? ((R & ~31) + perm32(R & 31)) : R;
        voffA[i] = (unsigned)(R * g.lda + C) * 2u; voffB[i] = (unsigned)(Rb * g.ldb + C) * 2u; }
    const size_t kstep = (size_t)(BK * 2);
    const size_t hstepA = (size_t)HALF * g.lda * 2, hstepB = (size_t)HALF * g.ldb * 2;
    const size_t tstepA = 2 * hstepA, tstepB = 2 * hstepB;
    const unsigned ldsw = (unsigned)wid * 1024u;
    const int aoff = lds_byte(wr * 64 + fr, fq * 8), boff = lds_byte(wc * 32 + fr, fq * 8);
#define PG8_SA(b, h) (((b) * 2 + (h)) * HTB)
#define PG8_SB(b, h) ((4 + (b) * 2 + (h)) * HTB)
#define PG8_STAGE(bufoff, gbase, voff) do { _Pragma("unroll") for (int _i = 0; _i < 2; ++_i) \
        __builtin_amdgcn_global_load_lds((const unsigned*)((const char*)(gbase) + (voff)[_i]), (LAS unsigned*)(lds + (bufoff) + ldsw + _i * 8192), 16, 0, 0); } while (0)
#define PG8_LDA(dst, b, h) do { _Pragma("unroll") for (int m = 0; m < 4; ++m) _Pragma("unroll") for (int k = 0; k < 2; ++k) dst[m][k] = *(const LAS bf16x8*)(lds + PG8_SA(b, h) + aoff + m * 2048 + k * 1024); } while (0)
#define PG8_LDB(dst, b, h) do { _Pragma("unroll") for (int n = 0; n < 2; ++n) _Pragma("unroll") for (int k = 0; k < 2; ++k) dst[n][k] = *(const LAS bf16x8*)(lds + PG8_SB(b, h) + boff + n * 2048 + k * 1024); } while (0)
#define PG8_MMA(ai, bj, At, Bt) do { __builtin_amdgcn_s_setprio(1); _Pragma("unroll") for (int m = 0; m < 4; ++m) _Pragma("unroll") for (int n = 0; n < 2; ++n) _Pragma("unroll") for (int k = 0; k < 2; ++k) \
        acc[ai][bj][m][n] = __builtin_amdgcn_mfma_f32_16x16x32_bf16(Bt[n][k], At[m][k], acc[ai][bj][m][n], 0, 0, 0); __builtin_amdgcn_s_setprio(0); } while (0)
#define PG8_WAIT_V(n) asm volatile("s_waitcnt vmcnt(" #n ")" ::: "memory")
#define PG8_WAIT_L(n) asm volatile("s_waitcnt lgkmcnt(" #n ")" ::: "memory")
#define PG8_BAR __builtin_amdgcn_s_barrier()
#define PG8_SCHED __builtin_amdgcn_sched_barrier(0)
    Unit cur, nxt; int ui = 0;
    if (!S.next(0, cur)) return;
    f32x4 acc[2][2][4][2];
#pragma unroll
    for (int a = 0; a < 2; ++a)
#pragma unroll
        for (int b = 0; b < 2; ++b)
#pragma unroll
            for (int m = 0; m < 4; ++m)
#pragma unroll
                for (int n = 0; n < 2; ++n) acc[a][b][m][n] = (f32x4){0.f, 0.f, 0.f, 0.f};
    bf16x8 At[4][2], B0[2][2], B1[2][2];
    const char* cA = (const char*)g.A + (size_t)cur.pm * tstepA; const char* cB = (const char*)g.Bt + (size_t)cur.pn * tstepB;
    PG8_STAGE(PG8_SB(0, 0), cB, voffB); PG8_STAGE(PG8_SB(0, 1), cB + hstepB, voffB); PG8_STAGE(PG8_SA(0, 0), cA, voffA); PG8_STAGE(PG8_SA(0, 1), cA + hstepA, voffA);
    if (wr == 1) PG8_BAR;
    PG8_WAIT_V(2); PG8_BAR;
    PG8_STAGE(PG8_SB(1, 0), cB + kstep, voffB); PG8_STAGE(PG8_SA(1, 0), cA + kstep, voffA); PG8_STAGE(PG8_SB(1, 1), cB + hstepB + kstep, voffB);
    PG8_WAIT_V(6); PG8_BAR;
    for (;;) {
        const bool has_next = S.next(ui + 1, nxt);
        const char* nA = has_next ? (const char*)g.A + (size_t)nxt.pm * tstepA : cA; const char* nB = has_next ? (const char*)g.Bt + (size_t)nxt.pn * tstepB : cB;
        for (int t = 0; t < nt; t += 2) {
            const bool last = (t == nt - 2);
            const char* a1 = cA + (size_t)(t + 1) * kstep;
            const char* a2 = last ? nA : cA + (size_t)(t + 2) * kstep; const char* b2 = last ? nB : cB + (size_t)(t + 2) * kstep;
            const char* a3 = a2 + kstep; const char* b3 = b2 + kstep;
            PG8_LDB(B0, 0, 0); PG8_LDB(B1, 0, 1); PG8_SCHED; PG8_LDA(At, 0, 0); PG8_STAGE(PG8_SA(1, 1), a1 + hstepA, voffA);
            PG8_WAIT_V(8); PG8_WAIT_L(0); PG8_BAR; PG8_MMA(0, 0, At, B0); PG8_MMA(0, 1, At, B1); PG8_BAR; PG8_SCHED;
            PG8_LDA(At, 0, 1); PG8_STAGE(PG8_SB(0, 0), b2, voffB); PG8_STAGE(PG8_SB(0, 1), b2 + hstepB, voffB); PG8_STAGE(PG8_SA(0, 0), a2, voffA);
            PG8_WAIT_V(8); PG8_WAIT_L(0); PG8_BAR; PG8_MMA(1, 0, At, B0); PG8_MMA(1, 1, At, B1); PG8_BAR; PG8_SCHED;
            PG8_LDB(B0, 1, 0); PG8_LDB(B1, 1, 1); PG8_SCHED; PG8_LDA(At, 1, 0); PG8_STAGE(PG8_SA(0, 1), a2 + hstepA, voffA);
            PG8_WAIT_V(8); PG8_WAIT_L(0); PG8_BAR; PG8_MMA(0, 0, At, B0); PG8_MMA(0, 1, At, B1); PG8_BAR; PG8_SCHED;
            PG8_LDA(At, 1, 1); PG8_STAGE(PG8_SB(1, 0), b3, voffB); PG8_STAGE(PG8_SB(1, 1), b3 + hstepB, voffB); PG8_STAGE(PG8_SA(1, 0), a3, voffA);
            PG8_WAIT_V(8); PG8_WAIT_L(0); PG8_BAR; PG8_MMA(1, 0, At, B0); PG8_MMA(1, 1, At, B1); PG8_BAR; PG8_SCHED;
        }
        if (wr == 0) PG8_BAR;
        E(acc, cur, wr, wc, fr, fq);
        if (!has_next) break;
#pragma unroll
        for (int a = 0; a < 2; ++a)
#pragma unroll
            for (int b = 0; b < 2; ++b)
#pragma unroll
                for (int m = 0; m < 4; ++m)
#pragma unroll
                    for (int n = 0; n < 2; ++n) acc[a][b][m][n] = (f32x4){0.f, 0.f, 0.f, 0.f};
        cur = nxt; cA = nA; cB = nB; ++ui;
        if (wr == 1) PG8_BAR;
    }
    PG8_WAIT_V(0);
    PG8_BAR;
#undef PG8_SA
#undef PG8_SB
#undef PG8_STAGE
#undef PG8_LDA
#undef PG8_LDB
#undef PG8_MMA
#undef PG8_WAIT_V
#undef PG8_WAIT_L
#undef PG8_BAR
#undef PG8_SCHED
}

__device__ __forceinline__ void rope4(f32x4& v0, f32x4& v1, const float* rp, int i0) {
    const f32x4 c = *(const f32x4*)(rp + i0), s = *(const f32x4*)(rp + 32 + i0);
    const float a0 = v0[0] * c[0] - v0[1] * s[0], b0 = v0[1] * c[0] + v0[0] * s[0];
    const float a1 = v0[2] * c[1] - v0[3] * s[1], b1 = v0[3] * c[1] + v0[2] * s[1];
    const float a2 = v1[0] * c[2] - v1[1] * s[2], b2 = v1[1] * c[2] + v1[0] * s[2];
    const float a3 = v1[2] * c[3] - v1[3] * s[3], b3 = v1[3] * c[3] + v1[2] * s[3];
    v0 = (f32x4){a0, b0, a1, b1}; v1 = (f32x4){a2, b2, a3, b3};
}
__device__ __forceinline__ void store8(bf16_t* p, f32x4 v0, f32x4 v1) {
    u32x4 w; w.x = cvt_pk_bf16(v0[0], v0[1]); w.y = cvt_pk_bf16(v0[2], v0[3]); w.z = cvt_pk_bf16(v1[0], v1[1]); w.w = cvt_pk_bf16(v1[2], v1[3]);
    *(u32x4*)p = w;
}
template <int MODE> struct EpiBf {
    static constexpr bool PERM = true;
    bf16_t* O; int ldc; float* ssq; float* sskv; const float* rope;
    __device__ __forceinline__ void operator()(const f32x4 (&acc)[2][2][4][2], const Unit& u, int wr, int wc, int fr, int fq) const {
        const int row0 = u.pm * BM + wr * 64 + fr, colt = u.pn * BM + wc * 32 + 8 * fq;
#pragma unroll
        for (int ai = 0; ai < 2; ++ai)
#pragma unroll
            for (int m = 0; m < 4; ++m) {
                const int row = row0 + ai * HALF + m * 16;
                bf16_t* rowp = O + (size_t)row * ldc + colt;
                float rs = 1.f;
                if (MODE == 1) { const f32x4 a = *(const f32x4*)(ssq + (size_t)row * 8), b = *(const f32x4*)(ssq + (size_t)row * 8 + 4);
                    rs = __builtin_amdgcn_rsqf(((a[0] + a[1]) + (a[2] + a[3]) + (b[0] + b[1]) + (b[2] + b[3])) * (1.f / QL) + EPS); }
                if (MODE == 2) { const f32x4 a = *(const f32x4*)(sskv + (size_t)row * 4); rs = __builtin_amdgcn_rsqf(((a[0] + a[1]) + (a[2] + a[3])) * (1.f / KVL) + EPS); }
                const float* rp = rope + (size_t)(row & (SEQ - 1)) * 64;
                float ss = 0.f;
#pragma unroll
                for (int bj = 0; bj < 2; ++bj) {
                    f32x4 v0 = acc[ai][bj][m][0], v1 = acc[ai][bj][m][1];
                    if (MODE == 0) {
                        if (u.pn <= 2) ss += (v0[0] * v0[0] + v0[1] * v0[1]) + (v0[2] * v0[2] + v0[3] * v0[3]) + (v1[0] * v1[0] + v1[1] * v1[1]) + (v1[2] * v1[2] + v1[3] * v1[3]);
                        if (u.pn == 16 && bj == 0 && wc < 2) rope4(v0, v1, rp, wc * 16 + 4 * fq);
                    }
                    if (MODE == 1) {
                        v0 = v0 * rs; v1 = v1 * rs;
                        const int col = colt + bj * HALF, hh = col / 192, d = col - hh * 192;
                        if (d >= 128) rope4(v0, v1, rp, (d - 128) >> 1);
                    }
                    if (MODE == 2) { v0 = v0 * rs; v1 = v1 * rs; }
                    store8(rowp + bj * HALF, v0, v1);
                }
                if (MODE == 0) {
                    if (u.pn <= 2) { ss += __shfl_xor(ss, 16); ss += __shfl_xor(ss, 32);
                        if (fq == 0) { if (u.pn < 2) ssq[(size_t)row * 8 + u.pn * 4 + wc] = ss; else sskv[(size_t)row * 4 + wc] = ss; } }
                }
            }
    }
};
struct EpiOut {
    static constexpr bool PERM = false;
    const float* x; float* out; float* ssout;
    __device__ __forceinline__ void operator()(const f32x4 (&acc)[2][2][4][2], const Unit& u, int wr, int wc, int fr, int fq) const {
        const int col0 = u.pn * BM + wc * 32 + 4 * fq;
#pragma unroll
        for (int ai = 0; ai < 2; ++ai)
#pragma unroll
            for (int m = 0; m < 4; ++m) {
                const int row = u.pm * BM + ai * HALF + wr * 64 + m * 16 + fr; const size_t off = (size_t)row * DM + col0; float ss = 0.f;
#pragma unroll
                for (int bj = 0; bj < 2; ++bj)
#pragma unroll
                    for (int n = 0; n < 2; ++n) { const f32x4 xv = *(const f32x4*)(x + off + bj * HALF + n * 16); const f32x4 y = acc[ai][bj][m][n] + xv;
                        ss += (y[0] * y[0] + y[1] * y[1]) + (y[2] * y[2] + y[3] * y[3]); *(f32x4*)(out + off + bj * HALF + n * 16) = y; }
                ss += __shfl_xor(ss, 16); ss += __shfl_xor(ss, 32);
                if (fq == 0) ssout[(size_t)row * 32 + u.pn * 4 + wc] = ss;
                asm volatile("" ::: "memory");
            }
    }
};
}

namespace attn {
constexpr int KVBLK = 64;
__device__ __forceinline__ int crow(int r, int hi) { return (r & 3) + 8 * (r >> 2) + 4 * hi; }
template <int DQK, int DV> struct Cfg {
    static constexpr bool HAS_A = (DQK >= 128), HAS_B = (DQK != 128);
    static constexpr int NB = DV / 32;
    static constexpr int SHM_V = KVBLK * DV * 2, SHM_KA = HAS_A ? KVBLK * 256 : 0, SHM_KB = HAS_B ? KVBLK * 128 : 0, BUF = SHM_V + SHM_KA + SHM_KB;
    static constexpr int OFF_V = 0, OFF_KA = SHM_V, OFF_KB = SHM_V + SHM_KA;
    static constexpr int ND0 = DQK / 16;
};
__device__ __forceinline__ int kswzA(int row, int colB) { return row * 256 + (colB ^ ((row & 7) << 4)); }
__device__ __forceinline__ int kswzB(int row, int ch) { return row * 128 + ((ch ^ ((row >> 1) & 7)) << 4); }
template <int NB> __device__ __forceinline__ int v_st(int k, int c) { const int kk = (k & ~0xC) | ((k & 4) << 1) | ((k & 8) >> 1); return ((kk >> 3) * NB + (c >> 5)) * 512 + ((kk & 7) * 32 + (c & 31)) * 2; }
__device__ __forceinline__ int v_rd_base(int lane) { return ((lane & 3) << 3) | (((lane >> 2) & 3) << 6) | (((lane >> 4) & 1) << 5) | (((lane >> 5) & 1) << 8); }
__device__ __forceinline__ s16x4 vtr(const LAS unsigned char* p) { return __builtin_bit_cast(s16x4, __builtin_amdgcn_ds_read_tr16_b64_v4i16((LAS v4i16_t*)p)); }
constexpr float THR2 = 11.5f;

template <int DQK, int DV, int MODE, int SD>
__device__ __forceinline__ void attn_unit(LAS unsigned char* lds,
        const bf16_t* __restrict__ Qp, int ldq,
        const bf16_t* __restrict__ KAp, int ldka,
        const bf16_t* __restrict__ KBp, int ldkb,
        const bf16_t* __restrict__ Vp, int ldv,
        const bf16_t* __restrict__ Zp, int ldz,
        bf16_t* __restrict__ Op, int ldo,
        int t0, int nt,
        int qchunk0,
        const float* __restrict__ biasg, float sink2, int qpos0) {
    using C = Cfg<DQK, DV>;
    int tid = threadIdx.x; asm volatile("" : "+v"(tid));
    const int lane = tid & 63, r32 = lane & 31, hi = lane >> 5;
    const int wid = __builtin_amdgcn_readfirstlane(tid >> 6), rg = wid & 3, kh = wid >> 2;
    LAS float* wsf = (LAS float*)(lds + AT_WS_OFF) + wid * 64;
    LAS float* biasl = (LAS float*)(lds + AT_BIAS_OFF);
    const int chunk_w = qchunk0 + (rg >> 1);
    bf16x8 qr[C::ND0];
    { const bf16_t* Qw = Qp + (size_t)(rg * 32 + r32) * ldq + hi * 8;
#pragma unroll
      for (int d0 = 0; d0 < C::ND0; ++d0) qr[d0] = *(const bf16x8*)(Qw + d0 * 16); }
    if (MODE == 1) { if (tid < 256) biasl[tid] = biasg[tid]; }
    const int sr = tid >> 4, sc = (tid & 15) * 8;
    const int br = tid >> 3, bc = (tid & 7) * 8;
    constexpr int SE = 0, SO = SD - 1;
    bf16x8 sv0[SD], sv1[SD], sa0[SD], sa1[SD], sb[SD];
#define SLOAD(i, t) do { const size_t k0_ = (size_t)(t) * KVBLK; \
        if (DV == 128) { sv0[i] = *(const bf16x8*)(Vp + (k0_ + sr) * ldv + sc); sv1[i] = *(const bf16x8*)(Vp + (k0_ + 32 + sr) * ldv + sc); } \
        else { sv0[i] = *(const bf16x8*)(Vp + (k0_ + br) * ldv + bc); } \
        if (C::HAS_A) { sa0[i] = *(const bf16x8*)(KAp + (k0_ + sr) * ldka + sc); sa1[i] = *(const bf16x8*)(KAp + (k0_ + 32 + sr) * ldka + sc); } \
        if (C::HAS_B) { sb[i] = *(const bf16x8*)(KBp + (k0_ + br) * ldkb + bc); } } while (0)
#define SWRITE(b, i) do { LAS unsigned char* bb_ = lds + (b) * C::BUF; \
        if (DV == 128) { *(LAS bf16x8*)(bb_ + C::OFF_V + v_st<C::NB>(sr, sc)) = sv0[i]; *(LAS bf16x8*)(bb_ + C::OFF_V + v_st<C::NB>(32 + sr, sc)) = sv1[i]; } \
        else { *(LAS bf16x8*)(bb_ + C::OFF_V + v_st<C::NB>(br, bc)) = sv0[i]; } \
        if (C::HAS_A) { *(LAS bf16x8*)(bb_ + C::OFF_KA + kswzA(sr, sc * 2)) = sa0[i]; *(LAS bf16x8*)(bb_ + C::OFF_KA + kswzA(32 + sr, sc * 2)) = sa1[i]; } \
        if (C::HAS_B) { *(LAS bf16x8*)(bb_ + C::OFF_KB + kswzB(br, tid & 7)) = sb[i]; } } while (0)
    float m_reg = -1e30f, l_reg = 0.f; f32x16 o[C::NB];
#pragma unroll
    for (int d = 0; d < C::NB; ++d) o[d] = f32x16{};
    const int krow = kh * 32 + r32;
#define QKT(P, b, t) do { const LAS unsigned char* bb_ = lds + (b) * C::BUF; P = f32x16{}; \
        if (C::HAS_A) { _Pragma("unroll") for (int d0 = 0; d0 < 8; ++d0) { const bf16x8 kf = *(const LAS bf16x8*)(bb_ + C::OFF_KA + kswzA(krow, (d0 * 16 + hi * 8) * 2)); \
            P = __builtin_amdgcn_mfma_f32_32x32x16_bf16(kf, qr[d0], P, 0, 0, 0); } } \
        if (C::HAS_B) { _Pragma("unroll") for (int d0 = 0; d0 < 4; ++d0) { const bf16x8 kf = *(const LAS bf16x8*)(bb_ + C::OFF_KB + kswzB(krow, d0 * 2 + hi)); \
            P = __builtin_amdgcn_mfma_f32_32x32x16_bf16(kf, qr[(C::HAS_A ? 8 : 0) + d0], P, 0, 0, 0); } } \
        if (MODE == 1) { const int rel0_ = ((t) * KVBLK + kh * 32 + 4 * hi) - (qpos0 + rg * 32 + r32) + 191; \
            _Pragma("unroll") for (int r = 0; r < 16; ++r) P[r] += biasl[rel0_ + (r & 3) + 8 * (r >> 2)]; } \
        { bool valid_ = true; if (MODE == 0) valid_ = ((t) <= chunk_w); if (MODE == 1) valid_ = ((t) <= chunk_w) && ((t) >= chunk_w - 2); \
          if (!valid_) { _Pragma("unroll") for (int r = 0; r < 16; ++r) P[r] = -INFINITY; } } } while (0)
#define PARTIAL(P, ALPHA) do { float pm_ = P[0]; _Pragma("unroll") for (int r = 1; r < 16; ++r) pm_ = fmaxf(pm_, P[r]); \
        { auto rr_ = __builtin_amdgcn_permlane32_swap(__float_as_uint(pm_), __float_as_uint(pm_), false, false); pm_ = fmaxf(__uint_as_float(rr_[0]), __uint_as_float(rr_[1])); } \
        float mn_; if (__builtin_expect(__all(pm_ - m_reg <= THR2), 1)) { mn_ = m_reg; ALPHA = 1.f; } \
        else { mn_ = fmaxf(m_reg, pm_); ALPHA = __builtin_amdgcn_exp2f(m_reg - mn_); m_reg = mn_; } \
        _Pragma("unroll") for (int r = 0; r < 16; ++r) P[r] = __builtin_amdgcn_exp2f(P[r] - mn_); } while (0)
#define PK4(P, BASE, OUT) do { unsigned a0_ = cvt_pk_bf16(P[BASE + 0], P[BASE + 1]), a1_ = cvt_pk_bf16(P[BASE + 2], P[BASE + 3]); \
        unsigned b0_ = cvt_pk_bf16(P[BASE + 4], P[BASE + 5]), b1_ = cvt_pk_bf16(P[BASE + 6], P[BASE + 7]); \
        auto r0_ = __builtin_amdgcn_permlane32_swap(a0_, b0_, false, false); auto r1_ = __builtin_amdgcn_permlane32_swap(a1_, b1_, false, false); \
        u32x4 w_ = {r0_[0], r1_[0], r0_[1], r1_[1]}; OUT = __builtin_bit_cast(bf16x8, w_); } while (0)
#define FINISH(P, ALPHA) do { float ps_ = 0.f; _Pragma("unroll") for (int r = 0; r < 16; ++r) ps_ += P[r]; \
        { auto rr_ = __builtin_amdgcn_permlane32_swap(__float_as_uint(ps_), __float_as_uint(ps_), false, false); ps_ = __uint_as_float(rr_[0]) + __uint_as_float(rr_[1]); } \
        l_reg = l_reg * ALPHA + ps_; PK4(P, 0, pa0); PK4(P, 8, pa1); } while (0)
    const int vrb = v_rd_base(lane) + kh * 2 * (2 * C::NB * 512);
#define PV(b) do { const LAS unsigned char* vb_ = lds + (b) * C::BUF + C::OFF_V + vrb; \
        _Pragma("unroll") for (int d0 = 0; d0 < C::NB; ++d0) { \
            const s16x4 l0_ = vtr(vb_ + d0 * 512), h0_ = vtr(vb_ + d0 * 512 + C::NB * 512); \
            const s16x4 l1_ = vtr(vb_ + d0 * 512 + 2 * C::NB * 512), h1_ = vtr(vb_ + d0 * 512 + 3 * C::NB * 512); \
            o[d0] = __builtin_amdgcn_mfma_f32_32x32x16_bf16(pa0, (bf16x8){l0_[0], l0_[1], l0_[2], l0_[3], h0_[0], h0_[1], h0_[2], h0_[3]}, o[d0], 0, 0, 0); \
            o[d0] = __builtin_amdgcn_mfma_f32_32x32x16_bf16(pa1, (bf16x8){l1_[0], l1_[1], l1_[2], l1_[3], h1_[0], h1_[1], h1_[2], h1_[3]}, o[d0], 0, 0, 0); } } while (0)
#define RESC(a) do { if (__any((a) < 1.f)) { if (hi == 0) wsf[r32] = (a); \
        _Pragma("unroll") for (int d = 0; d < C::NB; ++d) _Pragma("unroll") for (int r = 0; r < 16; ++r) o[d][r] *= wsf[crow(r, hi)]; } } while (0)
    f32x16 pA, pB; float alA, alB; bf16x8 pa0, pa1;
    SLOAD(SE, t0); SWRITE(0, SE); __syncthreads();
    QKT(pA, 0, t0); PARTIAL(pA, alA);
    SLOAD(SO, t0 + 1); if (SD == 2) { if (2 < nt) SLOAD(SE, t0 + 2); }
    SWRITE(1, SO); __syncthreads();
    for (int j = 1; j + 1 < nt; j += 2) {
        QKT(pB, 1, t0 + j);
        FINISH(pA, alA);
        SLOAD(SO, t0 + j + SD);
        PV(0); PARTIAL(pB, alB);
        __syncthreads(); SWRITE(0, SE);
        RESC(alB); __syncthreads();
        QKT(pA, 0, t0 + j + 1);
        FINISH(pB, alB);
        if (SD == 1 || j + 3 < nt) SLOAD(SE, t0 + j + 1 + SD);
        PV(1); PARTIAL(pA, alA);
        __syncthreads(); SWRITE(1, SO);
        RESC(alA); __syncthreads();
    }
    QKT(pB, 1, t0 + nt - 1);
    FINISH(pA, alA);
    PV(0); PARTIAL(pB, alB);
    RESC(alB);
    FINISH(pB, alB);
    PV(1);
    __syncthreads();
    LAS float* mrgO = (LAS float*)lds + rg * (32 * DV);
    LAS float* stg = (LAS float*)(lds + 65536) + rg * (32 * DV);
    LAS float* mlm = (LAS float*)(lds + AT_ML_OFF) + rg * 64;
    if (kh == 1) {
#pragma unroll
        for (int d = 0; d < C::NB; ++d)
#pragma unroll
            for (int r = 0; r < 16; ++r) mrgO[(d * 16 + r) * 64 + lane] = o[d][r];
        if (hi == 0) { mlm[r32] = m_reg; mlm[32 + r32] = l_reg; }
    }
    __syncthreads();
    if (kh == 0) {
        const float m1 = mlm[r32], l1 = mlm[32 + r32];
        const float mx = fmaxf(m_reg, m1), a0 = __builtin_amdgcn_exp2f(m_reg - mx), a1 = __builtin_amdgcn_exp2f(m1 - mx);
        float l = l_reg * a0 + l1 * a1;
        if (MODE == 1) l += __builtin_amdgcn_exp2f(sink2 - mx);
        const float il = 1.0f / l;
        if (hi == 0) { wsf[r32] = a0 * il; wsf[32 + r32] = a1 * il; }
#pragma unroll
        for (int r = 0; r < 16; ++r) { const int rw = crow(r, hi); const float f0 = wsf[rw], f1 = wsf[32 + rw];
#pragma unroll
            for (int d = 0; d < C::NB; ++d) stg[rw * DV + d * 32 + r32] = o[d][r] * f0 + mrgO[(d * 16 + r) * 64 + lane] * f1; }
        constexpr int CPR = DV / 8;
#pragma unroll
        for (int it = 0; it < (32 * CPR) / 64; ++it) {
            const int idx = it * 64 + lane, row = idx / CPR, ch = idx % CPR;
            const f32x4 x0 = *(const LAS f32x4*)(stg + row * DV + ch * 8), x1 = *(const LAS f32x4*)(stg + row * DV + ch * 8 + 4);
            const bf16x8 zz = *(const bf16x8*)(Zp + (size_t)(rg * 32 + row) * ldz + ch * 8);
            float g[8];
#pragma unroll
            for (int e = 0; e < 8; ++e) { const float z = bf2f((unsigned short)zz[e]); g[e] = z / (1.0f + __expf(-z)); }
            u32x4 w; w.x = cvt_pk_bf16(x0[0] * g[0], x0[1] * g[1]); w.y = cvt_pk_bf16(x0[2] * g[2], x0[3] * g[3]);
            w.z = cvt_pk_bf16(x1[0] * g[4], x1[1] * g[5]); w.w = cvt_pk_bf16(x1[2] * g[6], x1[3] * g[7]);
            *(u32x4*)(Op + (size_t)(rg * 32 + row) * ldo + ch * 8) = w;
        }
    }
    __syncthreads();
#undef SLOAD
#undef SWRITE
#undef QKT
#undef PARTIAL
#undef PK4
#undef FINISH
#undef PV
#undef RESC
}
}

#define XB_TMO      128
#define XB_XCNT(j)  (256  + 64 * (j))
#define XB_XSUB(j)  (1280 + 64 * (j))
#define XB_XGEN(j)  (2304 + 64 * (j))
#define XB_TOP      3328
#define XB_TOPGEN   3392
#define XCD_BAR_WORDS 3456
#define XB_SPIN_CAP (1u << 18)
__device__ __forceinline__ unsigned xb_ld(unsigned* p)              { return __hip_atomic_load(p, __ATOMIC_RELAXED, __HIP_MEMORY_SCOPE_AGENT); }
__device__ __forceinline__ unsigned xb_add(unsigned* p, unsigned v) { return __hip_atomic_fetch_add(p, v, __ATOMIC_RELAXED, __HIP_MEMORY_SCOPE_AGENT); }
__device__ __forceinline__ unsigned xb_xcc_id() { return (unsigned)__builtin_amdgcn_s_getreg((3 << 11) | 20) & 0xFu; }
#define XB_SPIN(cond, bar) do { unsigned _sp = 0; while (cond) { __builtin_amdgcn_s_sleep(1); \
    if ((++_sp & 255u) == 0u) { if (xb_ld(&(bar)[XB_TMO])) break; if (_sp > XB_SPIN_CAP) { atomicAdd(&(bar)[XB_TMO], 1u); break; } } } } while (0)
struct XcdBarrier { unsigned* bar; unsigned x; volatile LAS unsigned* st; };
__device__ __forceinline__ XcdBarrier xcd_barrier_post(unsigned* bar, volatile LAS unsigned* st) {
    XcdBarrier b; b.bar = bar; b.x = xb_xcc_id(); b.st = st;
    if (threadIdx.x == 0) (void)xb_add(&bar[XB_XCNT(b.x)], 1u);
    return b;
}
__device__ __forceinline__ void xcd_barrier_complete(unsigned* bar, unsigned x, unsigned& nloc, unsigned& nx) {
    const unsigned G = gridDim.x * gridDim.y * gridDim.z;
    unsigned sum, cnt, mine, sp = 0u;
    for (;;) {
        sum = 0u; cnt = 0u; mine = 0u;
#pragma unroll
        for (unsigned j = 0; j < 16; ++j) { const unsigned c = xb_ld(&bar[XB_XCNT(j)]); sum += c; cnt += (c > 0u) ? 1u : 0u; mine = (j == x) ? c : mine; }
        if (sum == G) break;
        __builtin_amdgcn_s_sleep(1);
        if ((++sp & 255u) == 0u) { if (xb_ld(&bar[XB_TMO])) break; if (sp > XB_SPIN_CAP) { atomicAdd(&bar[XB_TMO], 1u); break; } }
    }
    nloc = mine > 0u ? mine : 1u; nx = cnt > 0u ? cnt : 1u;
}
__device__ __forceinline__ void xcd_barrier(const XcdBarrier& b) {
    asm volatile("s_waitcnt vmcnt(0)" ::: "memory");
    __syncthreads();
    if (threadIdx.x == 0) {
        unsigned* bar = b.bar;
        __builtin_amdgcn_s_waitcnt(0);
        unsigned nloc = b.st[0], nx = b.st[1];
        if (nloc == 0u) { xcd_barrier_complete(bar, b.x, nloc, nx); b.st[0] = nloc; b.st[1] = nx; }
        const unsigned old = xb_add(&bar[XB_XSUB(b.x)], 1u);
        const unsigned gen = old / nloc;
        if (old + 1u == (gen + 1u) * nloc) {
            __builtin_amdgcn_fence(__ATOMIC_RELEASE, "agent");
            asm volatile("s_waitcnt vmcnt(0)" ::: "memory");
            const unsigned og = xb_add(&bar[XB_TOP], 1u);
            const unsigned tg = og / nx;
            if (og + 1u == (tg + 1u) * nx) xb_add(&bar[XB_TOPGEN], 1u);
            else XB_SPIN(xb_ld(&bar[XB_TOPGEN]) == tg, bar);
            __builtin_amdgcn_fence(__ATOMIC_ACQUIRE, "agent");
            xb_add(&bar[XB_XGEN(b.x)], 1u);
            asm volatile("s_waitcnt vmcnt(0)" ::: "memory");
        } else {
            XB_SPIN(xb_ld(&bar[XB_XGEN(b.x)]) == gen, bar);
            __builtin_amdgcn_fence(__ATOMIC_ACQUIRE, "agent");
            asm volatile("s_waitcnt vmcnt(0)" ::: "memory");
        }
    }
    __syncthreads();
}

__device__ __forceinline__ unsigned f2bf(float f) { unsigned u = __builtin_bit_cast(unsigned, f); return (u + 0x7fffu + ((u >> 16) & 1u)) >> 16; }
__device__ __forceinline__ unsigned pk2(float lo, float hi) { return f2bf(lo) | (f2bf(hi) << 16); }
__device__ __forceinline__ int il64(int j) { return j < 32 ? 2 * j : 2 * (j - 32) + 1; }
template <int WHICH>
__device__ __forceinline__ void p0_transpose_item(const float* W, int K, int N, bf16_t* WT, const float* gk, LAS float* scr, int item, int lane) {
    const int nblk = N / 32, kb = item / nblk, nb = item % nblk, k0 = 64 * kb, n0 = 32 * nb;
#pragma unroll 8
    for (int i = 0; i < 32; ++i) { const int kk = 2 * i + (lane >> 5); float v = W[(size_t)(k0 + kk) * N + n0 + (lane & 31)]; if (gk) v *= gk[k0 + kk]; scr[kk * 33 + (lane & 31)] = v; }
    LDS_WAIT(); asm volatile("" ::: "memory");
    const int c = lane & 7;
#pragma unroll
    for (int j = 0; j < 4; ++j) { const int n = (lane >> 3) + 8 * j; const LAS float* s = scr + (8 * c) * 33 + n;
        const int sn = n0 + n; int dn = sn; float cs = 1.f;
        if (WHICH == 0) { if (sn >= 768 && sn < 832) dn = PC_KPE + il64(sn - 768); else if (sn >= 832) dn = sn - 64;
            if (sn >= 1856 && sn < 2368) cs = 0.125f * LOG2E; if (sn >= 3136 && sn < 3648) cs = 0.08838834764831845f * LOG2E; }
        if (WHICH == 1) { const int hh = sn / 192, d = sn - hh * 192; if (d >= 128) dn = hh * 192 + 128 + il64(d - 128); cs = 0.07216878364870323f * LOG2E; }
        u32x4 o; o.x = pk2(s[0 * 33] * cs, s[1 * 33] * cs); o.y = pk2(s[2 * 33] * cs, s[3 * 33] * cs); o.z = pk2(s[4 * 33] * cs, s[5 * 33] * cs); o.w = pk2(s[6 * 33] * cs, s[7 * 33] * cs);
        *(GAS u32x4*)(WT + (size_t)dn * K + k0 + 8 * c) = o; }
    LDS_WAIT(); asm volatile("" ::: "memory");
}
__device__ __forceinline__ void rms_row_to_bf16(const float* xrow, const float* g, bf16_t* orow, int lane) {
    const GAS f32x4* xr = (const GAS f32x4*)xrow + lane; const GAS f32x4* gr = (const GAS f32x4*)g + lane;
    f32x4 v[8]; float s = 0.f;
#pragma unroll
    for (int j = 0; j < 8; ++j) { v[j] = xr[64 * j]; s += (v[j].x * v[j].x + v[j].y * v[j].y) + (v[j].z * v[j].z + v[j].w * v[j].w); }
    const float rstd = 1.0f / sqrtf(wave_sum(s) * (1.f / DM) + EPS);
    GAS unsigned long long* o8 = (GAS unsigned long long*)orow + lane;
#pragma unroll
    for (int j = 0; j < 8; ++j) { const f32x4 gg = gr[64 * j];
        o8[64 * j] = (unsigned long long)pk2(v[j].x * rstd * gg.x, v[j].y * rstd * gg.y) | ((unsigned long long)pk2(v[j].z * rstd * gg.z, v[j].w * rstd * gg.w) << 32); }
}
__device__ __forceinline__ void sincos_f(float ang, float& sn, float& cs) {
    const double a = (double)ang; const double kq = __builtin_rint(a * 0.6366197723675814); const int q = (int)kq;
    const float r = (float)(a - kq * 1.5707963267948966), r2 = r * r;
    const float sp = r + r * r2 * (-1.6666654611e-1f + r2 * (8.3321608736e-3f + r2 * (-1.9515295891e-4f)));
    const float cp = 1.0f - 0.5f * r2 + r2 * r2 * (4.166664568298827e-2f + r2 * (-1.388731625493765e-3f + r2 * 2.443315711809948e-5f));
    const int qq = q & 3;
    sn = (qq == 0) ? sp : (qq == 1) ? cp : (qq == 2) ? -sp : -cp;
    cs = (qq == 0) ? cp : (qq == 1) ? -sp : (qq == 2) ? -cp : sp;
}
__device__ __forceinline__ int t5_bucket(int rel) {
    const int b = rel > 0 ? 16 : 0; const int n = rel < 0 ? -rel : rel; if (n < 8) return b + n;
    const int nn = n * n; int j = 0; while ((64 << (j + 1)) <= nn) ++j;
    const int large = (8 + j) < 15 ? (8 + j) : 15; return b + large;
}

struct Args { const float* in[14]; float* out; unsigned char* ws; };
__global__ void __launch_bounds__(NWAVES * 64, 2) hybrid_fwd(Args args) {
    extern __shared__ __attribute__((aligned(16))) unsigned char lds_raw[];
    LAS unsigned char* lds = (LAS unsigned char*)lds_raw;
    volatile LAS unsigned* MISC = (volatile LAS unsigned*)(lds + MISC_OFF);
    const int tid = threadIdx.x, lane = tid & 63, wave = __builtin_amdgcn_readfirstlane(tid >> 6);
    const int G = gridDim.x; const int bx = blockIdx.x; const int vcu = (G % 8 == 0) ? (bx % 8) * (G / 8) + bx / 8 : bx;
    unsigned char* ws = args.ws;
    gu32* ctl = (gu32*)(ws + WS_CTL);
    const float* x = args.in[0]; const float* mem = args.in[1]; const float* g_in = args.in[2]; const float* w_in = args.in[3];
    const float* g_q = args.in[4]; const float* g_kv = args.in[5]; const float* w_uq = args.in[6]; const float* w_ukv = args.in[7];
    const float* sinks = args.in[8]; const float* rel_bias = args.in[9]; const float* g_mem = args.in[10]; const float* w_mem = args.in[11];
    const float* w_out = args.in[12]; const float* g_fin = args.in[13];
    float* out = args.out;
    float* SSQ = (float*)(ws + WS_SSQ); float* SSKV = (float*)(ws + WS_SSKV); float* SSOUT = (float*)(ws + WS_SSOUT);
    float* ROPE = (float*)(ws + WS_ROPE); float* BIAS = (float*)(ws + WS_BIAS);
    bf16_t* WIN = (bf16_t*)(ws + WS_WIN); bf16_t* WUQ = (bf16_t*)(ws + WS_WUQ); bf16_t* WUKV = (bf16_t*)(ws + WS_WUKV); bf16_t* WMEM = (bf16_t*)(ws + WS_WMEM); bf16_t* WOUT = (bf16_t*)(ws + WS_WOUT);
    bf16_t* MEMN = (bf16_t*)(ws + WS_MEMN); bf16_t* MEMKV = (bf16_t*)(ws + WS_MEMKV); bf16_t* H = (bf16_t*)(ws + WS_H); bf16_t* PROJ = (bf16_t*)(ws + WS_PROJ);
    bf16_t* Q = (bf16_t*)(ws + WS_Q); bf16_t* KV = (bf16_t*)(ws + WS_KV); bf16_t* MIX = (bf16_t*)(ws + WS_MIX);

    for (int u = tid; u < (LDS_BYTES - LDSCTL_OFF) / 4; u += NWAVES * 64) ((LAS unsigned*)(lds + LDSCTL_OFF))[u] = 0u;
    __syncthreads();
    XcdBarrier bar = xcd_barrier_post((unsigned*)(ctl + CW_BAR), MISC + 8);
    const int gw = vcu * NWAVES + wave, NGW = G * NWAVES;

    {
        LAS float* scr = (LAS float*)(lds + wave * 16384);
        constexpr int I_IN = (DM / 64) * (NIN / 32), I_UQ = (QL / 64) * (NQ / 32), I_UKV = (KVL / 64) * (NKV / 32), I_MEM = (DM / 64) * (NMKV / 32), I_OUT = (DM / 64) * (DM / 32);
        constexpr int NITEMS = I_IN + I_UQ + I_UKV + I_MEM + I_OUT;
        for (int it = gw; it < NITEMS; it += NGW) {
            int r = it;
            if (r < I_IN) { p0_transpose_item<0>(w_in, DM, NIN, WIN, nullptr, scr, r, lane); continue; } r -= I_IN;
            if (r < I_UQ) { p0_transpose_item<1>(w_uq, QL, NQ, WUQ, g_q, scr, r, lane); continue; } r -= I_UQ;
            if (r < I_UKV) { p0_transpose_item<2>(w_ukv, KVL, NKV, WUKV, g_kv, scr, r, lane); continue; } r -= I_UKV;
            if (r < I_MEM) { p0_transpose_item<2>(w_mem, DM, NMKV, WMEM, nullptr, scr, r, lane); continue; } r -= I_MEM;
            p0_transpose_item<2>(w_out, DM, DM, WOUT, nullptr, scr, r, lane);
        }
        for (int m = gw; m < M; m += NGW) rms_row_to_bf16(x + (size_t)m * DM, g_in, H + (size_t)m * DM, lane);
        for (int m = gw; m < MMEM; m += NGW) rms_row_to_bf16(mem + (size_t)m * DM, g_mem, MEMN + (size_t)m * DM, lane);
        for (int e = bx * 512 + tid; e < SEQ * 32; e += G * 512) { const int pos = e >> 5, i = e & 31;
            const float inv = 1.0f / powf(10000.0f, (float)(2 * i) / 64.0f); const float ang = (float)pos * inv; float sn, cs; sincos_f(ang, sn, cs);
            ROPE[pos * 64 + i] = cs; ROPE[pos * 64 + 32 + i] = sn; }
        if (bx == 0) { for (int e = tid; e < 8 * 256; e += 512) { const int hh = e >> 8, ri = e & 255; const int rel = ri - 191; BIAS[e] = (ri < 255) ? rel_bias[t5_bucket(rel) * 8 + hh] * LOG2E : 0.f; } }
    }
    xcd_barrier(bar);

    if (PHASE_MASK & 1) {
        { pg8::Gemm g{H, WIN, M, NPROJ, DM, DM, DM}; pg8::StaticOrder S; S.init(M, NPROJ, G, bx);
          pg8::EpiBf<0> E{PROJ, NPROJ, SSQ, SSKV, ROPE}; pg8::gemm_phase(lds, g, S, E); }
        { pg8::Gemm g{MEMN, WMEM, MMEM, NMKV, DM, DM, DM}; pg8::StaticOrder S; S.init(MMEM, NMKV, G, (bx + 8) % G);
          pg8::EpiBf<3> E{MEMKV, NMKV, nullptr, nullptr, ROPE}; pg8::gemm_phase(lds, g, S, E); }
    }
    xcd_barrier(bar);

    if (PHASE_MASK & 2) {
        { pg8::Gemm g{PROJ + PC_CQ, WUQ, M, NQ, QL, NPROJ, QL}; pg8::StaticOrder S; S.init(M, NQ, G, bx);
          pg8::EpiBf<1> E{Q, NQ, SSQ, SSKV, ROPE}; pg8::gemm_phase(lds, g, S, E); }
        { pg8::Gemm g{PROJ + PC_CKV, WUKV, M, NKV, KVL, NPROJ, KVL}; pg8::StaticOrder S; S.init(M, NKV, G, bx);
          pg8::EpiBf<2> E{KV, NKV, SSQ, SSKV, ROPE}; pg8::gemm_phase(lds, g, S, E); }
    }
    xcd_barrier(bar);

    {
        if (PHASE_MASK & 4) {
            for (int i = 0; i < 2; ++i) {
                const int p = vcu; const int bh = p >> 4, j = p & 15; const int qb = (i == 0) ? 31 - j : j; const int b = bh >> 3, hh = bh & 7;
                const size_t r0 = (size_t)b * SEQ, q0 = r0 + (size_t)qb * 128;
                attn::attn_unit<192, 128, 0, MLA_SD>(lds, Q + q0 * NQ + hh * 192, NQ, KV + r0 * NKV + hh * 256, NKV, PROJ + r0 * NPROJ + PC_KPE, NPROJ, KV + r0 * NKV + hh * 256 + 128, NKV,
                    PROJ + q0 * NPROJ + PC_ZMLA + hh * 128, NPROJ, MIX + q0 * DM + hh * 128, DM, 0, 2 * qb + 2, 2 * qb, nullptr, 0.f, 0);
            }
        }
        if (PHASE_MASK & 8) {
            for (int i = 0; i < 2; ++i) {
                const int u = 2 * vcu + i; const int bh = u >> 5, qb = u & 31; const int b = bh >> 3, hh = bh & 7, kvh = hh >> 2;
                const size_t r0 = (size_t)b * SEQ, q0 = r0 + (size_t)qb * 128;
                const int t0 = (qb == 0) ? 0 : 2 * qb - 2, nt = (qb == 0) ? 2 : 4;
                attn::attn_unit<64, 64, 1, 2>(lds, PROJ + q0 * NPROJ + PC_QSWA + hh * 64, NPROJ, nullptr, 0, PROJ + r0 * NPROJ + PC_KSWA + kvh * 64, NPROJ, PROJ + r0 * NPROJ + PC_VSWA + kvh * 64, NPROJ,
                    PROJ + q0 * NPROJ + PC_ZSWA + hh * 64, NPROJ, MIX + q0 * DM + 1024 + hh * 64, DM, t0, nt, 2 * qb, BIAS + hh * 256, sinks[hh] * LOG2E, qb * 128);
            }
        }
        if (PHASE_MASK & 16) {
            const int u = vcu; const int bh = u >> 5, qb = u & 31; const int b = bh >> 2, hh = bh & 3;
            const size_t r0 = (size_t)b * SEQ, q0 = r0 + (size_t)qb * 128; const size_t m0 = (size_t)b * NMEM;
            attn::attn_unit<128, 128, 2, 2>(lds, PROJ + q0 * NPROJ + PC_QMEM + hh * 128, NPROJ, MEMKV + m0 * NMKV + hh * 128, NMKV, nullptr, 0, MEMKV + m0 * NMKV + 512 + hh * 128, NMKV,
                PROJ + q0 * NPROJ + PC_ZMEM + hh * 128, NPROJ, MIX + q0 * DM + 1536 + hh * 128, DM, 0, 4, 0, nullptr, 0.f, 0);
        }
        if ((PHASE_MASK & 28) != 28) {
            for (int m = gw; m < M; m += NGW) { u32x4 z = {0u, 0u, 0u, 0u};
                if (!(PHASE_MASK & 4)) { *(u32x4*)(MIX + (size_t)m * DM + lane * 8) = z; *(u32x4*)(MIX + (size_t)m * DM + 512 + lane * 8) = z; }
                if (!(PHASE_MASK & 8)) *(u32x4*)(MIX + (size_t)m * DM + 1024 + lane * 8) = z;
                if (!(PHASE_MASK & 16)) *(u32x4*)(MIX + (size_t)m * DM + 1536 + lane * 8) = z; }
        }
    }
    xcd_barrier(bar);

    if (PHASE_MASK & 32) {
        pg8::Gemm g{MIX, WOUT, M, DM, DM, DM, DM}; pg8::StaticOrder S; S.init(M, DM, G, bx);
        pg8::EpiOut E{x, out, SSOUT}; pg8::gemm_phase(lds, g, S, E);
    }
    xcd_barrier(bar);

    {
        const bool poison = (xb_ld((unsigned*)(ctl + CW_BAR) + XB_TMO) != 0u);
        int tid5 = threadIdx.x; asm volatile("" : "+v"(tid5)); const int lane = tid5 & 63; const int gw = vcu * NWAVES + __builtin_amdgcn_readfirstlane(tid5 >> 6);
        for (int m = gw; m < M; m += NGW) {
            const GAS f32x4* gr = (const GAS f32x4*)g_fin + lane;
            if (PHASE_MASK & 32) {
                GAS f32x4* yr = (GAS f32x4*)(out + (size_t)m * DM) + lane;
                float s = (lane < 32) ? SSOUT[(size_t)m * 32 + lane] : 0.f; s = wave_sum(s);
                float rstd = 1.0f / sqrtf(s * (1.f / DM) + EPS); if (poison) rstd = __builtin_nanf("");
#pragma unroll
                for (int j = 0; j < 8; ++j) { const f32x4 v = yr[64 * j]; const f32x4 gg = gr[64 * j]; yr[64 * j] = v * rstd * gg; }
            } else {
                const GAS f32x4* xr = (const GAS f32x4*)(x + (size_t)m * DM) + lane; GAS f32x4* yr = (GAS f32x4*)(out + (size_t)m * DM) + lane;
                f32x4 v[8]; float s = 0.f;
#pragma unroll
                for (int j = 0; j < 8; ++j) { v[j] = xr[64 * j]; s += (v[j].x * v[j].x + v[j].y * v[j].y) + (v[j].z * v[j].z + v[j].w * v[j].w); }
                const float rstd = 1.0f / sqrtf(wave_sum(s) * (1.f / DM) + EPS);
#pragma unroll
                for (int j = 0; j < 8; ++j) { const f32x4 gg = gr[64 * j]; yr[64 * j] = v[j] * rstd * gg; }
            }
        }
    }
}

extern "C" void kernel_launch(void* const* d_in, const int* in_sizes, int n_in, void* d_out, int out_size, void* d_ws, size_t ws_size, hipStream_t stream) {
    static int grid = 0;
    if (grid == 0) {
        if (n_in != 14 || in_sizes[0] != M * DM || out_size != M * DM || ws_size < WS_END) { fprintf(stderr, "kernel_launch: unexpected shapes (n_in %d, in0 %d, out %d, ws %zu)\n", n_in, n_in > 0 ? in_sizes[0] : -1, out_size, ws_size); grid = -1; return; }
        int dev = 0, cus = 0, per_cu = 0;
        if (hipGetDevice(&dev) != hipSuccess || hipDeviceGetAttribute(&cus, hipDeviceAttributeMultiprocessorCount, dev) != hipSuccess) { grid = -1; return; }
        if (hipFuncSetAttribute((const void*)hybrid_fwd, hipFuncAttributeMaxDynamicSharedMemorySize, LDS_BYTES) != hipSuccess) { fprintf(stderr, "kernel_launch: hipFuncSetAttribute failed\n"); grid = -1; return; }
        if (hipOccupancyMaxActiveBlocksPerMultiprocessor(&per_cu, (const void*)hybrid_fwd, NWAVES * 64, LDS_BYTES) != hipSuccess || per_cu < 1)
            fprintf(stderr, "kernel_launch: note: occupancy query reports %d workgroups per CU\n", per_cu);
        (void)hipGetLastError();
        grid = cus;
        if (grid != 256) fprintf(stderr, "kernel_launch: note: %d CUs\n", grid);
    }
    if (grid < 0) return;
    (void)hipMemsetAsync((char*)d_ws + WS_CTL, 0, CTL_ZERO_BYTES, stream);
    Args a{};
    for (int i = 0; i < 14; ++i) a.in[i] = (const float*)d_in[i];
    a.out = (float*)d_out; a.ws = (unsigned char*)d_ws;
    hipLaunchKernelGGL(hybrid_fwd, dim3(grid), dim3(NWAVES * 64), LDS_BYTES, stream, a);
}
```

```cpp
#include <hip/hip_runtime.h>
#include <hip/hip_bf16.h>
#include <cstdio>
#include <cstdint>

#ifndef PHASE_MASK
#define PHASE_MASK 0xFF
#endif

#ifndef DBL_PHASE
#define DBL_PHASE -1
#endif
#ifndef TS_PROBE
#define TS_PROBE 0
#endif
#ifndef TS_A
#define TS_A 1
#endif
#ifndef TS_B
#define TS_B 3
#endif
#ifndef TS_MODE
#define TS_MODE 0
#endif
#ifndef MLA_SD
#define MLA_SD 1
#endif
#define LAS __attribute__((address_space(3)))
#define GAS __attribute__((address_space(1)))
typedef unsigned short bf16_t;
typedef short bf16x8 __attribute__((ext_vector_type(8)));
typedef short s16x4 __attribute__((ext_vector_type(4)));
typedef short v4i16_t __attribute__((ext_vector_type(4)));
typedef float f32x2 __attribute__((ext_vector_type(2)));
typedef float f32x4 __attribute__((ext_vector_type(4)));
typedef float f32x16 __attribute__((ext_vector_type(16)));
typedef unsigned u32x2 __attribute__((ext_vector_type(2)));
typedef unsigned u32x4 __attribute__((ext_vector_type(4)));
typedef GAS unsigned gu32;

constexpr int BATCH = 2, SEQ = 4096, DM = 2048, M = BATCH * SEQ;
constexpr int NMEM = 256, MMEM = BATCH * NMEM;
constexpr int NIN = 4160, NPROJ = 4352;
constexpr int QL = 512, KVL = 256;
constexpr int NQ = 1536, NKV = 2048;
constexpr int NMKV = 1024;
constexpr float EPS = 1e-6f;
constexpr float LOG2E = 1.4426950408889634f;
constexpr int PC_CQ = 0, PC_CKV = 512, PC_ZMLA = 768, PC_QSWA = 1792, PC_KSWA = 2304, PC_VSWA = 2432, PC_ZSWA = 2560, PC_QMEM = 3072, PC_ZMEM = 3584, PC_KPE = 4096;

constexpr size_t MiB = 1u << 20;
constexpr size_t WS_CTL = 0, CTL_ZERO_BYTES = 65536;
constexpr size_t WS_SSQ = 1 * MiB, WS_SSKV = WS_SSQ + 256 * 1024, WS_SSOUT = 2 * MiB, WS_ROPE = 3 * MiB, WS_BIAS = 4 * MiB;
constexpr size_t WS_TS = 4 * MiB + 65536;
constexpr size_t WS_WIN = 5 * MiB, WS_WUQ = 22 * MiB, WS_WUKV = 24 * MiB, WS_WMEM = 25 * MiB, WS_WOUT = 29 * MiB;
constexpr size_t WS_MEMN = 37 * MiB, WS_MEMKV = 39 * MiB, WS_H = 40 * MiB, WS_PROJ = 72 * MiB, WS_Q = 140 * MiB, WS_KV = 164 * MiB, WS_MIX = 196 * MiB, WS_END = 228 * MiB;
constexpr int CW_BAR = 4096;

constexpr int RING_BYTES = 131072;
constexpr int LDSCTL_OFF = RING_BYTES, MISC_OFF = LDSCTL_OFF + 320;
constexpr int AT_WS_OFF = RING_BYTES + 1024;
constexpr int AT_BIAS_OFF = AT_WS_OFF + 2048;
constexpr int AT_ML_OFF = AT_BIAS_OFF + 1024;
constexpr int LDS_BYTES = 147456;
constexpr int NWAVES = 8;

#define RLX_AGENT __ATOMIC_RELAXED, __HIP_MEMORY_SCOPE_AGENT
#define LDS_WAIT() asm volatile("s_waitcnt lgkmcnt(0)" ::: "memory")
#define VM_WAIT() asm volatile("s_waitcnt vmcnt(0)" ::: "memory")

__device__ __forceinline__ unsigned cvt_pk_bf16(float lo, float hi) { unsigned r; asm volatile("v_cvt_pk_bf16_f32 %0, %1, %2" : "=v"(r) : "v"(lo), "v"(hi)); return r; }
__device__ __forceinline__ float bf2f(unsigned short b) { return __builtin_bit_cast(float, (unsigned)b << 16); }
__device__ __forceinline__ float wave_sum(float v) {
#pragma unroll
    for (int o = 1; o < 64; o <<= 1) v += __shfl_xor(v, o);
    return v;
}

namespace pg8 {
constexpr int BM = 256, BK = 64, HALF = 128, HTB = HALF * BK * 2, STAGE_BYTES = 8 * HTB, NXCD = 8, WGM = 8;
__host__ __device__ __forceinline__ int lds_byte(int r, int c) { const int st = (r >> 4) * 2 + (c >> 5), rr = r & 15, cc = c & 31, ob = rr * 64 + cc * 2; return st * 1024 + (ob ^ (((ob >> 9) & 1) << 5)); }
__host__ __device__ __forceinline__ void stage_rc(int b, int& R, int& C) { const int st = b / 1024, sb = b % 1024, swz = sb ^ (((sb >> 9) & 1) << 5); R = (st >> 1) * 16 + swz / 64; C = (st & 1) * 32 + (swz % 64) / 2; }
__host__ __device__ __forceinline__ int perm32(int rho) { const int n = rho >> 4, i = rho & 15; return 8 * (i >> 2) + 4 * n + (i & 3); }

struct Unit { int pm, pn; };
struct Gemm { const bf16_t* A; const bf16_t* Bt; int M, N, K, lda, ldb; };

struct StaticOrder {
    int nM, nN, nwg, G, c, cnt;
    __device__ void init(int M_, int N_, int G_, int c_) { nM = M_ / BM; nN = N_ / BM; nwg = nM * nN; G = G_; c = c_; cnt = 1 << 30; }
    __device__ void init_range(int M_, int N_, int start, int stride, int count) { nM = M_ / BM; nN = N_ / BM; nwg = nM * nN; G = stride; c = start; cnt = count; }
    __device__ bool next(int i, Unit& u) const {
        const long L = (long)i * G + c; if (i >= cnt || L >= nwg) return false;
        int wgid = (int)L; { const int q = nwg / NXCD, r = nwg % NXCD, xcd = wgid % NXCD, off = wgid / NXCD; wgid = (xcd < r ? xcd * (q + 1) : r * (q + 1) + (xcd - r) * q) + off; }
        const int nig = WGM * nN, gid = wgid / nig, fm = gid * WGM, gsz = (nM - fm) < WGM ? (nM - fm) : WGM;
        u.pm = fm + ((wgid % nig) % gsz); u.pn = (wgid % nig) / gsz; return true;
    }
};

template <class Epi>
__device__ __forceinline__ void gemm_phase(LAS unsigned char* lds, const Gemm g, const StaticOrder& S, const Epi& E) {
    int tid = threadIdx.x; asm volatile("" : "+v"(tid));
    const int wid = __builtin_amdgcn_readfirstlane(tid >> 6), lane = tid & 63, wr = wid >> 2, wc = wid & 3, fr = lane & 15, fq = lane >> 4;
    const int K = g.K, nt = K / BK;
    unsigned voffA[2], voffB[2];
#pragma unroll
    for (int i = 0; i < 2; ++i) { int R, C; stage_rc(tid * 16 + i * 8192, R, C); const int Rb = Epi::PERM ? ((R & ~31) + perm32(R & 31)) : R;
        voffA[i] = (unsigned)(R * g.lda + C) * 2u; voffB[i] = (unsigned)(Rb * g.ldb + C) * 2u; }
    const size_t kstep = (size_t)(BK * 2);
    const size_t hstepA = (size_t)HALF * g.lda * 2, hstepB = (size_t)HALF * g.ldb * 2;
    const size_t tstepA = 2 * hstepA, tstepB = 2 * hstepB;
    const unsigned ldsw = (unsigned)wid * 1024u;
    const int aoff = lds_byte(wr * 64 + fr, fq * 8), boff = lds_byte(wc * 32 + fr, fq * 8);
#define PG8_SA(b, h) (((b) * 2 + (h)) * HTB)
#define PG8_SB(b, h) ((4 + (b) * 2 + (h)) * HTB)
#define PG8_STAGE(bufoff, gbase, voff) do { _Pragma("unroll") for (int _i = 0; _i < 2; ++_i) \
        __builtin_amdgcn_global_load_lds((const unsigned*)((const char*)(gbase) + (voff)[_i]), (LAS unsigned*)(lds + (bufoff) + ldsw + _i * 8192), 16, 0, 0); } while (0)
#define PG8_LDA(dst, b, h) do { _Pragma("unroll") for (int m = 0; m < 4; ++m) _Pragma("unroll") for (int k = 0; k < 2; ++k) dst[m][k] = *(const LAS bf16x8*)(lds + PG8_SA(b, h) + aoff + m * 2048 + k * 1024); } while (0)
#define PG8_LDB(dst, b, h) do { _Pragma("unroll") for (int n = 0; n < 2; ++n) _Pragma("unroll") for (int k = 0; k < 2; ++k) dst[n][k] = *(const LAS bf16x8*)(lds + PG8_SB(b, h) + boff + n * 2048 + k * 1024); } while (0)
#define PG8_MMA(ai, bj, At, Bt) do { __builtin_amdgcn_s_setprio(1); _Pragma("unroll") for (int m = 0; m < 4; ++m) _Pragma("unroll") for (int n = 0; n < 2; ++n) _Pragma("unroll") for (int k = 0; k < 2; ++k) \
        acc[ai][bj][m][n] = __builtin_amdgcn_mfma_f32_16x16x32_bf16(Bt[n][k], At[m][k], acc[ai][bj][m][n], 0, 0, 0); __builtin_amdgcn_s_setprio(0); } while (0)
#define PG8_WAIT_V(n) asm volatile("s_waitcnt vmcnt(" #n ")" ::: "memory")
#define PG8_WAIT_L(n) asm volatile("s_waitcnt lgkmcnt(" #n ")" ::: "memory")
#define PG8_BAR __builtin_amdgcn_s_barrier()
#define PG8_SCHED __builtin_amdgcn_sched_barrier(0)
    Unit cur, nxt; int ui = 0;
    if (!S.next(0, cur)) return;
    f32x4 acc[2][2][4][2];
#pragma unroll
    for (int a = 0; a < 2; ++a)
#pragma unroll
        for (int b = 0; b < 2; ++b)
#pragma unroll
            for (int m = 0; m < 4; ++m)
#pragma unroll
                for (int n = 0; n < 2; ++n) acc[a][b][m][n] = (f32x4){0.f, 0.f, 0.f, 0.f};
    bf16x8 At[4][2], B0[2][2], B1[2][2];
    const char* cA = (const char*)g.A + (size_t)cur.pm * tstepA; const char* cB = (const char*)g.Bt + (size_t)cur.pn * tstepB;
    PG8_STAGE(PG8_SB(0, 0), cB, voffB); PG8_STAGE(PG8_SB(0, 1), cB + hstepB, voffB); PG8_STAGE(PG8_SA(0, 0), cA, voffA); PG8_STAGE(PG8_SA(0, 1), cA + hstepA, voffA);
    if (wr == 1) PG8_BAR;
    PG8_WAIT_V(2); PG8_BAR;
    PG8_STAGE(PG8_SB(1, 0), cB + kstep, voffB); PG8_STAGE(PG8_SA(1, 0), cA + kstep, voffA); PG8_STAGE(PG8_SB(1, 1), cB + hstepB + kstep, voffB);
    PG8_WAIT_V(6); PG8_BAR;
    for (;;) {
        const bool has_next = S.next(ui + 1, nxt);
        const char* nA = has_next ? (const char*)g.A + (size_t)nxt.pm * tstepA : cA; const char* nB = has_next ? (const char*)g.Bt + (size_t)nxt.pn * tstepB : cB;
        for (int t = 0; t < nt; t += 2) {
            const bool last = (t == nt - 2);
            const char* a1 = cA + (size_t)(t + 1) * kstep;
            const char* a2 = last ? nA : cA + (size_t)(t + 2) * kstep; const char* b2 = last ? nB : cB + (size_t)(t + 2) * kstep;
            const char* a3 = a2 + kstep; const char* b3 = b2 + kstep;
            PG8_LDB(B0, 0, 0); PG8_LDB(B1, 0, 1); PG8_SCHED; PG8_LDA(At, 0, 0); PG8_STAGE(PG8_SA(1, 1), a1 + hstepA, voffA);
            PG8_WAIT_V(8); PG8_WAIT_L(0); PG8_BAR; PG8_MMA(0, 0, At, B0); PG8_MMA(0, 1, At, B1); PG8_BAR; PG8_SCHED;
            PG8_LDA(At, 0, 1); PG8_STAGE(PG8_SB(0, 0), b2, voffB); PG8_STAGE(PG8_SB(0, 1), b2 + hstepB, voffB); PG8_STAGE(PG8_SA(0, 0), a2, voffA);
            PG8_WAIT_V(8); PG8_WAIT_L(0); PG8_BAR; PG8_MMA(1, 0, At, B0); PG8_MMA(1, 1, At, B1); PG8_BAR; PG8_SCHED;
            PG8_LDB(B0, 1, 0); PG8_LDB(B1, 1, 1); PG8_SCHED; PG8_LDA(At, 1, 0); PG8_STAGE(PG8_SA(0, 1), a2 + hstepA, voffA);
            PG8_WAIT_V(8); PG8_WAIT_L(0); PG8_BAR; PG8_MMA(0, 0, At, B0); PG8_MMA(0, 1, At, B1); PG8_BAR; PG8_SCHED;
            PG8_LDA(At, 1, 1); PG8_STAGE(PG8_SB(1, 0), b3, voffB); PG8_STAGE(PG8_SB(1, 1), b3 + hstepB, voffB); PG8_STAGE(PG8_SA(1, 0), a3, voffA);
            PG8_WAIT_V(8); PG8_WAIT_L(0); PG8_BAR; PG8_MMA(1, 0, At, B0); PG8_MMA(1, 1, At, B1); PG8_BAR; PG8_SCHED;
        }
        if (wr == 0) PG8_BAR;
        E(acc, cur, wr, wc, fr, fq);
        if (!has_next) break;
#pragma unroll
        for (int a = 0; a < 2; ++a)
#pragma unroll
            for (int b = 0; b < 2; ++b)
#pragma unroll
                for (int m = 0; m < 4; ++m)
#pragma unroll
                    for (int n = 0; n < 2; ++n) acc[a][b][m][n] = (f32x4){0.f, 0.f, 0.f, 0.f};
        cur = nxt; cA = nA; cB = nB; ++ui;
        if (wr == 1) PG8_BAR;
    }
    PG8_WAIT_V(0);
    PG8_BAR;
#undef PG8_SA
#undef PG8_SB
#undef PG8_STAGE
#undef PG8_LDA
#undef PG8_LDB
#undef PG8_MMA
#undef PG8_WAIT_V
#undef PG8_WAIT_L
#undef PG8_BAR
#undef PG8_SCHED
}

__device__ __forceinline__ void rope4(f32x4& v0, f32x4& v1, const float* rp, int i0) {
    const f32x4 c = *(const f32x4*)(rp + i0), s = *(const f32x4*)(rp + 32 + i0);
    const float a0 = v0[0] * c[0] - v0[1] * s[0], b0 = v0[1] * c[0] + v0[0] * s[0];
    const float a1 = v0[2] * c[1] - v0[3] * s[1], b1 = v0[3] * c[1] + v0[2] * s[1];
    const float a2 = v1[0] * c[2] - v1[1] * s[2], b2 = v1[1] * c[2] + v1[0] * s[2];
    const float a3 = v1[2] * c[3] - v1[3] * s[3], b3 = v1[3] * c[3] + v1[2] * s[3];
    v0 = (f32x4){a0, b0, a1, b1}; v1 = (f32x4){a2, b2, a3, b3};
}
__device__ __forceinline__ void store8(bf16_t* p, f32x4 v0, f32x4 v1) {
    u32x4 w; w.x = cvt_pk_bf16(v0[0], v0[1]); w.y = cvt_pk_bf16(v0[2], v0[3]); w.z = cvt_pk_bf16(v1[0], v1[1]); w.w = cvt_pk_bf16(v1[2], v1[3]);
    *(u32x4*)p = w;
}
template <int MODE> struct EpiBf {
    static constexpr bool PERM = true;
    bf16_t* O; int ldc; float* ssq; float* sskv; const float* rope;
    __device__ __forceinline__ void operator()(const f32x4 (&acc)[2][2][4][2], const Unit& u, int wr, int wc, int fr, int fq) const {
        const int row0 = u.pm * BM + wr * 64 + fr, colt = u.pn * BM + wc * 32 + 8 * fq;
#pragma unroll
        for (int ai = 0; ai < 2; ++ai)
#pragma unroll
            for (int m = 0; m < 4; ++m) {
                const int row = row0 + ai * HALF + m * 16;
                bf16_t* rowp = O + (size_t)row * ldc + colt;
                float rs = 1.f;
                if (MODE == 1) { const f32x4 a = *(const f32x4*)(ssq + (size_t)row * 8), b = *(const f32x4*)(ssq + (size_t)row * 8 + 4);
                    rs = __builtin_amdgcn_rsqf(((a[0] + a[1]) + (a[2] + a[3]) + (b[0] + b[1]) + (b[2] + b[3])) * (1.f / QL) + EPS); }
                if (MODE == 2) { const f32x4 a = *(const f32x4*)(sskv + (size_t)row * 4); rs = __builtin_amdgcn_rsqf(((a[0] + a[1]) + (a[2] + a[3])) * (1.f / KVL) + EPS); }
                const float* rp = rope + (size_t)(row & (SEQ - 1)) * 64;
                float ss = 0.f;
#pragma unroll
                for (int bj = 0; bj < 2; ++bj) {
                    f32x4 v0 = acc[ai][bj][m][0], v1 = acc[ai][bj][m][1];
                    if (MODE == 0) {
                        if (u.pn <= 2) ss += (v0[0] * v0[0] + v0[1] * v0[1]) + (v0[2] * v0[2] + v0[3] * v0[3]) + (v1[0] * v1[0] + v1[1] * v1[1]) + (v1[2] * v1[2] + v1[3] * v1[3]);
                        if (u.pn == 16 && bj == 0 && wc < 2) rope4(v0, v1, rp, wc * 16 + 4 * fq);
                    }
                    if (MODE == 1) {
                        v0 = v0 * rs; v1 = v1 * rs;
                        const int col = colt + bj * HALF, hh = col / 192, d = col - hh * 192;
                        if (d >= 128) rope4(v0, v1, rp, (d - 128) >> 1);
                    }
                    if (MODE == 2) { v0 = v0 * rs; v1 = v1 * rs; }
                    if (MODE == 4) { if (bj == 0 && wc < 2) rope4(v0, v1, rp, wc * 16 + 4 * fq); }
                    store8(rowp + bj * HALF, v0, v1);
                }
                if (MODE == 0) {
                    if (u.pn <= 2) { ss += __shfl_xor(ss, 16); ss += __shfl_xor(ss, 32);
                        if (fq == 0) { if (u.pn < 2) ssq[(size_t)row * 8 + u.pn * 4 + wc] = ss; else sskv[(size_t)row * 4 + wc] = ss; } }
                }
            }
    }
};
struct EpiOut {
    static constexpr bool PERM = false;
    const float* x; float* out; float* ssout;
    __device__ __forceinline__ void operator()(const f32x4 (&acc)[2][2][4][2], const Unit& u, int wr, int wc, int fr, int fq) const {
        const int col0 = u.pn * BM + wc * 32 + 4 * fq;
#pragma unroll
        for (int ai = 0; ai < 2; ++ai)
#pragma unroll
            for (int m = 0; m < 4; ++m) {
                const int row = u.pm * BM + ai * HALF + wr * 64 + m * 16 + fr; const size_t off = (size_t)row * DM + col0; float ss = 0.f;
#pragma unroll
                for (int bj = 0; bj < 2; ++bj)
#pragma unroll
                    for (int n = 0; n < 2; ++n) { const f32x4 xv = *(const f32x4*)(x + off + bj * HALF + n * 16); const f32x4 y = acc[ai][bj][m][n] + xv;
                        ss += (y[0] * y[0] + y[1] * y[1]) + (y[2] * y[2] + y[3] * y[3]); *(f32x4*)(out + off + bj * HALF + n * 16) = y; }
                ss += __shfl_xor(ss, 16); ss += __shfl_xor(ss, 32);
                if (fq == 0) ssout[(size_t)row * 32 + u.pn * 4 + wc] = ss;
                asm volatile("" ::: "memory");
            }
    }
};
}

namespace attn {
constexpr int KVBLK = 64;
__device__ __forceinline__ int crow(int r, int hi) { return (r & 3) + 8 * (r >> 2) + 4 * hi; }
template <int DQK, int DV> struct Cfg {
    static constexpr bool HAS_A = (DQK >= 128), HAS_B = (DQK != 128);
    static constexpr int NB = DV / 32;
    static constexpr int KT = (HAS_A ? KVBLK * 256 : 0) + (HAS_B ? KVBLK * 128 : 0), VT = KVBLK * DV * 2;
    static constexpr int OFF_KB = HAS_A ? KVBLK * 256 : 0;
    static constexpr int KRING = 0, VRING = 3 * KT;
    static constexpr int NK = (HAS_A ? 2 : 0) + (HAS_B ? 1 : 0), NPV = VT / 8192, NV = NPV;
    static constexpr int ND0 = DQK / 16;
};
__device__ __forceinline__ int kswzA(int row, int colB) { return row * 256 + (colB ^ ((row & 15) << 4)); }
__device__ __forceinline__ int kswzB(int row, int ch) { return row * 128 + ((ch ^ ((row >> 1) & 7)) << 4); }
__device__ __forceinline__ int v_rd_base(int lane) { return ((lane & 3) << 3) | (((lane >> 2) & 3) << 6) | (((lane >> 4) & 1) << 5) | (((lane >> 5) & 1) << 8); }
__device__ __forceinline__ s16x4 vtr(const LAS unsigned char* p) { return __builtin_bit_cast(s16x4, __builtin_amdgcn_ds_read_tr16_b64_v4i16((LAS v4i16_t*)p)); }
__device__ __forceinline__ void glds16(const void* gsrc, unsigned lds_dst) { unsigned keep;
    asm volatile("s_mov_b32 %0, m0\n\ts_mov_b32 m0, %2\n\ts_nop 0\n\tglobal_load_lds_dwordx4 %1, off\n\ts_mov_b32 m0, %0" : "=&s"(keep) : "v"(gsrc), "s"(lds_dst) : "memory"); }
template <int N> __device__ __forceinline__ void wait_bar() { asm volatile("s_waitcnt vmcnt(%0) lgkmcnt(0)\n\ts_barrier" :: "n"(N) : "memory"); }
constexpr float THR2 = 11.5f;

template <int DQK, int DV, int MODE>
__device__ __forceinline__ void attn_unit(LAS unsigned char* lds,
        const bf16_t* __restrict__ Qp, int ldq, const bf16_t* __restrict__ KAp, int ldka, const bf16_t* __restrict__ KBp, int ldkb, const bf16_t* __restrict__ Vp, int ldv,
        const bf16_t* __restrict__ Zp, int ldz, bf16_t* __restrict__ Op, int ldo,
        int t0, int nt, int qchunk0, const float* __restrict__ biasg, float sink2, int qpos0) {
    using C = Cfg<DQK, DV>;
    int tid = threadIdx.x; asm volatile("" : "+v"(tid));
    const int lane = tid & 63, r32 = lane & 31, hi = lane >> 5;
    const int wid = __builtin_amdgcn_readfirstlane(tid >> 6), rg = wid & 3, kh = wid >> 2;
    LAS float* wsf = (LAS float*)(lds + AT_WS_OFF) + wid * 64;
    LAS float* biasl = (LAS float*)(lds + AT_BIAS_OFF);
    const int chunk_w = qchunk0 + (rg >> 1);
    const unsigned lds0 = (unsigned)(size_t)lds;
    int offA0 = 0, offA1 = 0, offB = 0, offV0 = 0, offV1 = 0;
    if (C::HAS_A) { { const int row = 4 * (2 * wid) + (lane >> 4); offA0 = row * ldka + (((lane & 15) ^ (row & 15)) << 3); }
                    { const int row = 4 * (2 * wid + 1) + (lane >> 4); offA1 = row * ldka + (((lane & 15) ^ (row & 15)) << 3); } }
    if (C::HAS_B) { const int row = 8 * wid + (lane >> 3); offB = row * ldkb + (((lane & 7) ^ ((row >> 1) & 7)) << 3); }
    { const int p = wid * C::NPV, si = 2 * p + (lane >> 5), kk = (si / C::NB) * 8 + ((lane >> 2) & 7), k = (kk & ~0xC) | ((kk & 4) << 1) | ((kk & 8) >> 1);
      offV0 = k * ldv + (si % C::NB) * 32 + (lane & 3) * 8; }
    if (C::NPV == 2) { const int p = wid * 2 + 1, si = 2 * p + (lane >> 5), kk = (si / C::NB) * 8 + ((lane >> 2) & 7), k = (kk & ~0xC) | ((kk & 4) << 1) | ((kk & 8) >> 1);
      offV1 = k * ldv + (si % C::NB) * 32 + (lane & 3) * 8; }
    const unsigned kdst = lds0 + C::KRING, vdst = lds0 + C::VRING + wid * C::NPV * 1024;
#define DMA_K(j, slot) do { const size_t tb_ = (size_t)(t0 + (j)) * KVBLK; const unsigned kd_ = kdst + (slot) * C::KT; \
        if (C::HAS_A) { glds16(KAp + tb_ * ldka + offA0, (unsigned)__builtin_amdgcn_readfirstlane(kd_ + wid * 2048)); glds16(KAp + tb_ * ldka + offA1, (unsigned)__builtin_amdgcn_readfirstlane(kd_ + wid * 2048 + 1024)); } \
        if (C::HAS_B) { glds16(KBp + tb_ * ldkb + offB, (unsigned)__builtin_amdgcn_readfirstlane(kd_ + C::OFF_KB + wid * 1024)); } } while (0)
#define DMA_V(j, slot) do { const size_t tb_ = (size_t)(t0 + (j)) * KVBLK; const unsigned vd_ = vdst + (slot) * C::VT; \
        glds16(Vp + tb_ * ldv + offV0, (unsigned)__builtin_amdgcn_readfirstlane(vd_)); \
        if (C::NPV == 2) glds16(Vp + tb_ * ldv + offV1, (unsigned)__builtin_amdgcn_readfirstlane(vd_ + 1024)); } while (0)
    DMA_K(0, 0); DMA_V(0, 0); DMA_K(1, 1);
    bf16x8 qr[C::ND0];
    { const bf16_t* Qw = Qp + (size_t)(rg * 32 + r32) * ldq + hi * 8;
#pragma unroll
      for (int d0 = 0; d0 < C::ND0; ++d0) qr[d0] = *(const bf16x8*)(Qw + d0 * 16); }
    if (MODE == 1) { if (tid < 256) biasl[tid] = biasg[tid]; }
    float m_reg = -1e30f, l_reg = 0.f; f32x16 o[C::NB];
#pragma unroll
    for (int d = 0; d < C::NB; ++d) o[d] = f32x16{};
    const int krow = kh * 32 + r32;
    bf16x8 kf[C::ND0]; s16x4 vf[C::NB * 4];
#define KLOAD(ks) do { const LAS unsigned char* bb_ = lds + C::KRING + (ks) * C::KT; \
        if (C::HAS_A) { _Pragma("unroll") for (int d0 = 0; d0 < 8; ++d0) kf[d0] = *(const LAS bf16x8*)(bb_ + kswzA(krow, (d0 * 16 + hi * 8) * 2)); } \
        if (C::HAS_B) { _Pragma("unroll") for (int d0 = 0; d0 < 4; ++d0) kf[(C::HAS_A ? 8 : 0) + d0] = *(const LAS bf16x8*)(bb_ + C::OFF_KB + kswzB(krow, d0 * 2 + hi)); } } while (0)
#define QKT(P, j) do { P = f32x16{}; \
        _Pragma("unroll") for (int d0 = 0; d0 < C::ND0; ++d0) P = __builtin_amdgcn_mfma_f32_32x32x16_bf16(kf[d0], qr[d0], P, 0, 0, 0); \
        if (MODE == 1) { const int rel0_ = ((t0 + (j)) * KVBLK + kh * 32 + 4 * hi) - (qpos0 + rg * 32 + r32) + 191; \
            _Pragma("unroll") for (int r = 0; r < 16; ++r) P[r] += biasl[rel0_ + (r & 3) + 8 * (r >> 2)]; } \
        { bool valid_ = true; if (MODE == 0) valid_ = ((t0 + (j)) <= chunk_w); if (MODE == 1) valid_ = ((t0 + (j)) <= chunk_w) && ((t0 + (j)) >= chunk_w - 2); \
          if (!valid_) { _Pragma("unroll") for (int r = 0; r < 16; ++r) P[r] = -INFINITY; } } } while (0)
#define PARTIAL(P, ALPHA) do { float pm_ = P[0]; _Pragma("unroll") for (int r = 1; r < 16; ++r) pm_ = fmaxf(pm_, P[r]); \
        { auto rr_ = __builtin_amdgcn_permlane32_swap(__float_as_uint(pm_), __float_as_uint(pm_), false, false); pm_ = fmaxf(__uint_as_float(rr_[0]), __uint_as_float(rr_[1])); } \
        float mn_; if (__builtin_expect(__all(pm_ - m_reg <= THR2), 1)) { mn_ = m_reg; ALPHA = 1.f; } \
        else { mn_ = fmaxf(m_reg, pm_); ALPHA = __builtin_amdgcn_exp2f(m_reg - mn_); m_reg = mn_; } \
        _Pragma("unroll") for (int r = 0; r < 16; ++r) P[r] = __builtin_amdgcn_exp2f(P[r] - mn_); } while (0)
#define PK4(P, BASE, OUT) do { unsigned a0_ = cvt_pk_bf16(P[BASE + 0], P[BASE + 1]), a1_ = cvt_pk_bf16(P[BASE + 2], P[BASE + 3]); \
        unsigned b0_ = cvt_pk_bf16(P[BASE + 4], P[BASE + 5]), b1_ = cvt_pk_bf16(P[BASE + 6], P[BASE + 7]); \
        auto r0_ = __builtin_amdgcn_permlane32_swap(a0_, b0_, false, false); auto r1_ = __builtin_amdgcn_permlane32_swap(a1_, b1_, false, false); \
        u32x4 w_ = {r0_[0], r1_[0], r0_[1], r1_[1]}; OUT = __builtin_bit_cast(bf16x8, w_); } while (0)
#define FINISH(P, ALPHA) do { float ps_ = 0.f; _Pragma("unroll") for (int r = 0; r < 16; ++r) ps_ += P[r]; \
        { auto rr_ = __builtin_amdgcn_permlane32_swap(__float_as_uint(ps_), __float_as_uint(ps_), false, false); ps_ = __uint_as_float(rr_[0]) + __uint_as_float(rr_[1]); } \
        l_reg = l_reg * ALPHA + ps_; PK4(P, 0, pa0); PK4(P, 8, pa1); } while (0)
    const int vrb = C::VRING + v_rd_base(lane) + kh * 2 * (2 * C::NB * 512);
#define VLOAD(vs) do { const LAS unsigned char* vb_ = lds + (vs) * C::VT + vrb; \
        _Pragma("unroll") for (int d0 = 0; d0 < C::NB; ++d0) { vf[d0 * 4 + 0] = vtr(vb_ + d0 * 512); vf[d0 * 4 + 1] = vtr(vb_ + d0 * 512 + C::NB * 512); \
            vf[d0 * 4 + 2] = vtr(vb_ + d0 * 512 + 2 * C::NB * 512); vf[d0 * 4 + 3] = vtr(vb_ + d0 * 512 + 3 * C::NB * 512); } } while (0)
#define PVM() do { _Pragma("unroll") for (int d0 = 0; d0 < C::NB; ++d0) { \
            const s16x4 l0_ = vf[d0 * 4 + 0], h0_ = vf[d0 * 4 + 1], l1_ = vf[d0 * 4 + 2], h1_ = vf[d0 * 4 + 3]; \
            o[d0] = __builtin_amdgcn_mfma_f32_32x32x16_bf16(pa0, (bf16x8){l0_[0], l0_[1], l0_[2], l0_[3], h0_[0], h0_[1], h0_[2], h0_[3]}, o[d0], 0, 0, 0); \
            o[d0] = __builtin_amdgcn_mfma_f32_32x32x16_bf16(pa1, (bf16x8){l1_[0], l1_[1], l1_[2], l1_[3], h1_[0], h1_[1], h1_[2], h1_[3]}, o[d0], 0, 0, 0); } } while (0)
#define RESC(a) do { if (__any((a) < 1.f)) { if (hi == 0) wsf[r32] = (a); \
        _Pragma("unroll") for (int d = 0; d < C::NB; ++d) _Pragma("unroll") for (int r = 0; r < 16; ++r) o[d][r] *= wsf[crow(r, hi)]; } } while (0)
#define ENDSTEP(j) do { if ((j) + 2 < nt) wait_bar<C::NK + C::NV>(); else if ((j) + 1 < nt) wait_bar<C::NV>(); else wait_bar<0>(); } while (0)
#define SOFTMAX(P) do { float al_; PARTIAL(P, al_); RESC(al_); FINISH(P, al_); } while (0)
#define DMA_STEP(j) do { if ((j) + 2 < nt) DMA_K((j) + 2, sa); if ((j) + 1 < nt) DMA_V((j) + 1, sc); } while (0)
#define MPART(j) do { if ((j) > 0) VLOAD(sa); KLOAD(sb); __builtin_amdgcn_sched_barrier(0); if ((j) > 0) PVM(); QKT(pA, j); __builtin_amdgcn_sched_barrier(0); } while (0)
    f32x16 pA; bf16x8 pa0, pa1;
    int sa = 2, sb = 0, sc = 1;
    wait_bar<C::NV + C::NK>();
    DMA_STEP(0); MPART(0); SOFTMAX(pA); ENDSTEP(0); { const int t_ = sa; sa = sb; sb = sc; sc = t_; }
    for (int j = 1; j < nt; ++j) { DMA_STEP(j); MPART(j); SOFTMAX(pA); ENDSTEP(j); { const int t_ = sa; sa = sb; sb = sc; sc = t_; } }
    VLOAD(sa); PVM();
    constexpr int CPR = DV / 8, NZ = DV / 32;
    bf16x8 zz[NZ]; int zrow[NZ], zch[NZ];
#pragma unroll
    for (int i = 0; i < NZ; ++i) { const int idx = i * 64 + lane; zrow[i] = rg * 32 + kh * 16 + idx / CPR; zch[i] = idx % CPR; zz[i] = *(const bf16x8*)(Zp + (size_t)zrow[i] * ldz + zch[i] * 8); }
    __syncthreads();
    LAS float* mrgO = (LAS float*)lds + rg * (32 * DV);
    LAS float* stg = (LAS float*)(lds + 65536);
    LAS float* mlm = (LAS float*)(lds + AT_ML_OFF) + rg * 64;
    if (kh == 1) {
#pragma unroll
        for (int d = 0; d < C::NB; ++d)
#pragma unroll
            for (int r = 0; r < 16; ++r) mrgO[(d * 16 + r) * 64 + lane] = o[d][r];
        if (hi == 0) { mlm[r32] = m_reg; mlm[32 + r32] = l_reg; }
    }
    __syncthreads();
    if (kh == 0) {
        const float m1 = mlm[r32], l1 = mlm[32 + r32];
        const float mx = fmaxf(m_reg, m1), a0 = __builtin_amdgcn_exp2f(m_reg - mx), a1 = __builtin_amdgcn_exp2f(m1 - mx);
        float l = l_reg * a0 + l1 * a1;
        if (MODE == 1) l += __builtin_amdgcn_exp2f(sink2 - mx);
        const float il = 1.0f / l;
        if (hi == 0) { wsf[r32] = a0 * il; wsf[32 + r32] = a1 * il; }
#pragma unroll
        for (int r = 0; r < 16; ++r) { const int rw = crow(r, hi); const float f0 = wsf[rw], f1 = wsf[32 + rw];
#pragma unroll
            for (int d = 0; d < C::NB; ++d) stg[(rg * 32 + rw) * DV + d * 32 + r32] = o[d][r] * f0 + mrgO[(d * 16 + r) * 64 + lane] * f1; }
    }
    __syncthreads();
#pragma unroll
    for (int i = 0; i < NZ; ++i) {
        const f32x4 x0 = *(const LAS f32x4*)(stg + zrow[i] * DV + zch[i] * 8), x1 = *(const LAS f32x4*)(stg + zrow[i] * DV + zch[i] * 8 + 4);
        float g[8];
#pragma unroll
        for (int e = 0; e < 8; ++e) { const float z = bf2f((unsigned short)zz[i][e]); g[e] = z / (1.0f + __expf(-z)); }
        u32x4 w; w.x = cvt_pk_bf16(x0[0] * g[0], x0[1] * g[1]); w.y = cvt_pk_bf16(x0[2] * g[2], x0[3] * g[3]);
        w.z = cvt_pk_bf16(x1[0] * g[4], x1[1] * g[5]); w.w = cvt_pk_bf16(x1[2] * g[6], x1[3] * g[7]);
        *(u32x4*)(Op + (size_t)zrow[i] * ldo + zch[i] * 8) = w;
    }
    __syncthreads();
#undef DMA_K
#undef DMA_V
#undef QKT
#undef PARTIAL
#undef PK4
#undef FINISH
#undef VLOAD
#undef PVM
#undef RESC
#undef ENDSTEP
#undef DMA_STEP
#undef MPART
#undef SOFTMAX
#undef KLOAD
}
}


#define XB_TMO      128
#define XB_XCNT(j)  (256  + 64 * (j))
#define XB_XSUB(j)  (1280 + 64 * (j))
#define XB_XGEN(j)  (2304 + 64 * (j))
#define XB_TOP      3328
#define XB_TOPGEN   3392
#define XCD_BAR_WORDS 3456
#define XB_SPIN_CAP (1u << 18)
__device__ __forceinline__ unsigned xb_ld(unsigned* p)              { return __hip_atomic_load(p, __ATOMIC_RELAXED, __HIP_MEMORY_SCOPE_AGENT); }
__device__ __forceinline__ unsigned xb_add(unsigned* p, unsigned v) { return __hip_atomic_fetch_add(p, v, __ATOMIC_RELAXED, __HIP_MEMORY_SCOPE_AGENT); }
__device__ __forceinline__ unsigned xb_xcc_id() { return (unsigned)__builtin_amdgcn_s_getreg((3 << 11) | 20) & 0xFu; }
#define XB_SPIN(cond, bar) do { unsigned _sp = 0; while (cond) { __builtin_amdgcn_s_sleep(1); \
    if ((++_sp & 255u) == 0u) { if (xb_ld(&(bar)[XB_TMO])) break; if (_sp > XB_SPIN_CAP) { atomicAdd(&(bar)[XB_TMO], 1u); break; } } } } while (0)
struct XcdBarrier { unsigned* bar; unsigned x; volatile LAS unsigned* st; };
__device__ __forceinline__ XcdBarrier xcd_barrier_post(unsigned* bar, volatile LAS unsigned* st) {
    XcdBarrier b; b.bar = bar; b.x = xb_xcc_id(); b.st = st;
    if (threadIdx.x == 0) (void)xb_add(&bar[XB_XCNT(b.x)], 1u);
    return b;
}
__device__ __forceinline__ void xcd_barrier_complete(unsigned* bar, unsigned x, unsigned& nloc, unsigned& nx) {
    const unsigned G = gridDim.x * gridDim.y * gridDim.z;
    unsigned sum, cnt, mine, sp = 0u;
    for (;;) {
        sum = 0u; cnt = 0u; mine = 0u;
#pragma unroll
        for (unsigned j = 0; j < 16; ++j) { const unsigned c = xb_ld(&bar[XB_XCNT(j)]); sum += c; cnt += (c > 0u) ? 1u : 0u; mine = (j == x) ? c : mine; }
        if (sum == G) break;
        __builtin_amdgcn_s_sleep(1);
        if ((++sp & 255u) == 0u) { if (xb_ld(&bar[XB_TMO])) break; if (sp > XB_SPIN_CAP) { atomicAdd(&bar[XB_TMO], 1u); break; } }
    }
    nloc = mine > 0u ? mine : 1u; nx = cnt > 0u ? cnt : 1u;
}
__device__ __forceinline__ void xcd_barrier(const XcdBarrier& b) {
    asm volatile("s_waitcnt vmcnt(0)" ::: "memory");
    __syncthreads();
    if (threadIdx.x == 0) {
        unsigned* bar = b.bar;
        __builtin_amdgcn_s_waitcnt(0);
        unsigned nloc = b.st[0], nx = b.st[1];
        if (nloc == 0u) { xcd_barrier_complete(bar, b.x, nloc, nx); b.st[0] = nloc; b.st[1] = nx; }
        const unsigned old = xb_add(&bar[XB_XSUB(b.x)], 1u);
        const unsigned gen = old / nloc;
        if (old + 1u == (gen + 1u) * nloc) {
            __builtin_amdgcn_fence(__ATOMIC_RELEASE, "agent");
            asm volatile("s_waitcnt vmcnt(0)" ::: "memory");
            const unsigned og = xb_add(&bar[XB_TOP], 1u);
            const unsigned tg = og / nx;
            if (og + 1u == (tg + 1u) * nx) xb_add(&bar[XB_TOPGEN], 1u);
            else XB_SPIN(xb_ld(&bar[XB_TOPGEN]) == tg, bar);
            __builtin_amdgcn_fence(__ATOMIC_ACQUIRE, "agent");
            xb_add(&bar[XB_XGEN(b.x)], 1u);
            asm volatile("s_waitcnt vmcnt(0)" ::: "memory");
        } else {
            XB_SPIN(xb_ld(&bar[XB_XGEN(b.x)]) == gen, bar);
            __builtin_amdgcn_fence(__ATOMIC_ACQUIRE, "agent");
            asm volatile("s_waitcnt vmcnt(0)" ::: "memory");
        }
    }
    __syncthreads();
}

__device__ __forceinline__ unsigned f2bf(float f) { unsigned u = __builtin_bit_cast(unsigned, f); return (u + 0x7fffu + ((u >> 16) & 1u)) >> 16; }
__device__ __forceinline__ unsigned pk2(float lo, float hi) { return f2bf(lo) | (f2bf(hi) << 16); }
__device__ __forceinline__ int il64(int j) { return j < 32 ? 2 * j : 2 * (j - 32) + 1; }
template <int WHICH>
__device__ __forceinline__ void p0_transpose_item(const float* W, int K, int N, bf16_t* WT, const float* gk, LAS float* scr, int item, int lane) {
    const int nblk = N / 32, kb = item / nblk, nb = item % nblk, k0 = 64 * kb, n0 = 32 * nb;
#pragma unroll 8
    for (int i = 0; i < 32; ++i) { const int kk = 2 * i + (lane >> 5); float v = W[(size_t)(k0 + kk) * N + n0 + (lane & 31)]; if (gk) v *= gk[k0 + kk]; scr[kk * 33 + (lane & 31)] = v; }
    LDS_WAIT(); asm volatile("" ::: "memory");
    const int c = lane & 7;
#pragma unroll
    for (int j = 0; j < 4; ++j) { const int n = (lane >> 3) + 8 * j; const LAS float* s = scr + (8 * c) * 33 + n;
        const int sn = n0 + n; int dn = sn; float cs = 1.f;
        if (WHICH == 0) { if (sn >= 768 && sn < 832) dn = PC_KPE + il64(sn - 768); else if (sn >= 832) dn = sn - 64;
            if (sn >= 1856 && sn < 2368) cs = 0.125f * LOG2E; if (sn >= 3136 && sn < 3648) cs = 0.08838834764831845f * LOG2E; }
        if (WHICH == 1) { const int hh = sn / 192, d = sn - hh * 192; if (d >= 128) dn = hh * 192 + 128 + il64(d - 128); cs = 0.07216878364870323f * LOG2E; }
        u32x4 o; o.x = pk2(s[0 * 33] * cs, s[1 * 33] * cs); o.y = pk2(s[2 * 33] * cs, s[3 * 33] * cs); o.z = pk2(s[4 * 33] * cs, s[5 * 33] * cs); o.w = pk2(s[6 * 33] * cs, s[7 * 33] * cs);
        *(GAS u32x4*)(WT + (size_t)dn * K + k0 + 8 * c) = o; }
    LDS_WAIT(); asm volatile("" ::: "memory");
}
__device__ __forceinline__ void rms_row_to_bf16(const float* xrow, const float* g, bf16_t* orow, int lane) {
    const GAS f32x4* xr = (const GAS f32x4*)xrow + lane; const GAS f32x4* gr = (const GAS f32x4*)g + lane;
    f32x4 v[8]; float s = 0.f;
#pragma unroll
    for (int j = 0; j < 8; ++j) { v[j] = xr[64 * j]; s += (v[j].x * v[j].x + v[j].y * v[j].y) + (v[j].z * v[j].z + v[j].w * v[j].w); }
    const float rstd = 1.0f / sqrtf(wave_sum(s) * (1.f / DM) + EPS);
    GAS unsigned long long* o8 = (GAS unsigned long long*)orow + lane;
#pragma unroll
    for (int j = 0; j < 8; ++j) { const f32x4 gg = gr[64 * j];
        o8[64 * j] = (unsigned long long)pk2(v[j].x * rstd * gg.x, v[j].y * rstd * gg.y) | ((unsigned long long)pk2(v[j].z * rstd * gg.z, v[j].w * rstd * gg.w) << 32); }
}
__device__ __forceinline__ void sincos_f(float ang, float& sn, float& cs) {
    const double a = (double)ang; const double kq = __builtin_rint(a * 0.6366197723675814); const int q = (int)kq;
    const float r = (float)(a - kq * 1.5707963267948966), r2 = r * r;
    const float sp = r + r * r2 * (-1.6666654611e-1f + r2 * (8.3321608736e-3f + r2 * (-1.9515295891e-4f)));
    const float cp = 1.0f - 0.5f * r2 + r2 * r2 * (4.166664568298827e-2f + r2 * (-1.388731625493765e-3f + r2 * 2.443315711809948e-5f));
    const int qq = q & 3;
    sn = (qq == 0) ? sp : (qq == 1) ? cp : (qq == 2) ? -sp : -cp;
    cs = (qq == 0) ? cp : (qq == 1) ? -sp : (qq == 2) ? -cp : sp;
}
__device__ __forceinline__ int t5_bucket(int rel) {
    const int b = rel > 0 ? 16 : 0; const int n = rel < 0 ? -rel : rel; if (n < 8) return b + n;
    const int nn = n * n; int j = 0; while ((64 << (j + 1)) <= nn) ++j;
    const int large = (8 + j) < 15 ? (8 + j) : 15; return b + large;
}

struct Args { const float* in[14]; float* out; unsigned char* ws; };
__global__ void __launch_bounds__(NWAVES * 64, 2) hybrid_fwd(Args args) {
    extern __shared__ __attribute__((aligned(16))) unsigned char lds_raw[];
    LAS unsigned char* lds = (LAS unsigned char*)lds_raw;
    volatile LAS unsigned* MISC = (volatile LAS unsigned*)(lds + MISC_OFF);
    const int tid = threadIdx.x, lane = tid & 63, wave = __builtin_amdgcn_readfirstlane(tid >> 6);
    const int G = gridDim.x; const int bx = blockIdx.x; const int vcu = (G % 8 == 0) ? (bx % 8) * (G / 8) + bx / 8 : bx;
    unsigned char* ws = args.ws;
    gu32* ctl = (gu32*)(ws + WS_CTL);
    const float* x = args.in[0]; const float* mem = args.in[1]; const float* g_in = args.in[2]; const float* w_in = args.in[3];
    const float* g_q = args.in[4]; const float* g_kv = args.in[5]; const float* w_uq = args.in[6]; const float* w_ukv = args.in[7];
    const float* sinks = args.in[8]; const float* rel_bias = args.in[9]; const float* g_mem = args.in[10]; const float* w_mem = args.in[11];
    const float* w_out = args.in[12]; const float* g_fin = args.in[13];
    float* out = args.out;
    float* SSQ = (float*)(ws + WS_SSQ); float* SSKV = (float*)(ws + WS_SSKV); float* SSOUT = (float*)(ws + WS_SSOUT);
    float* ROPE = (float*)(ws + WS_ROPE); float* BIAS = (float*)(ws + WS_BIAS);
    bf16_t* WIN = (bf16_t*)(ws + WS_WIN); bf16_t* WUQ = (bf16_t*)(ws + WS_WUQ); bf16_t* WUKV = (bf16_t*)(ws + WS_WUKV); bf16_t* WMEM = (bf16_t*)(ws + WS_WMEM); bf16_t* WOUT = (bf16_t*)(ws + WS_WOUT);
    bf16_t* MEMN = (bf16_t*)(ws + WS_MEMN); bf16_t* MEMKV = (bf16_t*)(ws + WS_MEMKV); bf16_t* H = (bf16_t*)(ws + WS_H); bf16_t* PROJ = (bf16_t*)(ws + WS_PROJ);
    bf16_t* Q = (bf16_t*)(ws + WS_Q); bf16_t* KV = (bf16_t*)(ws + WS_KV); bf16_t* MIX = (bf16_t*)(ws + WS_MIX);

    for (int u = tid; u < (LDS_BYTES - LDSCTL_OFF) / 4; u += NWAVES * 64) ((LAS unsigned*)(lds + LDSCTL_OFF))[u] = 0u;
    __syncthreads();
    XcdBarrier bar = xcd_barrier_post((unsigned*)(ctl + CW_BAR), MISC + 8);
    const int gw = vcu * NWAVES + wave, NGW = G * NWAVES;
    unsigned long long* TS = (unsigned long long*)(ws + WS_TS);
#define STAMP(k) do { if (TS_PROBE && tid == 0) TS[(k) * 256 + bx] = __builtin_amdgcn_s_memrealtime(); } while (0)
    STAMP(0);

    for (int rep = 0; rep < (DBL_PHASE == 0 ? 2 : 1); ++rep) {
        LAS float* scr = (LAS float*)(lds + wave * 16384);
        constexpr int I_IN = (DM / 64) * (NIN / 32), I_UQ = (QL / 64) * (NQ / 32), I_UKV = (KVL / 64) * (NKV / 32), I_MEM = (DM / 64) * (NMKV / 32), I_OUT = (DM / 64) * (DM / 32);
        constexpr int NITEMS = I_IN + I_UQ + I_UKV + I_MEM + I_OUT;
        for (int it = gw; it < NITEMS; it += NGW) {
            int r = it;
            if (r < I_IN) { p0_transpose_item<0>(w_in, DM, NIN, WIN, nullptr, scr, r, lane); continue; } r -= I_IN;
            if (r < I_UQ) { p0_transpose_item<1>(w_uq, QL, NQ, WUQ, g_q, scr, r, lane); continue; } r -= I_UQ;
            if (r < I_UKV) { p0_transpose_item<2>(w_ukv, KVL, NKV, WUKV, g_kv, scr, r, lane); continue; } r -= I_UKV;
            if (r < I_MEM) { p0_transpose_item<2>(w_mem, DM, NMKV, WMEM, nullptr, scr, r, lane); continue; } r -= I_MEM;
            p0_transpose_item<2>(w_out, DM, DM, WOUT, nullptr, scr, r, lane);
        }
        for (int m = gw; m < M; m += NGW) rms_row_to_bf16(x + (size_t)m * DM, g_in, H + (size_t)m * DM, lane);
        for (int m = gw; m < MMEM; m += NGW) rms_row_to_bf16(mem + (size_t)m * DM, g_mem, MEMN + (size_t)m * DM, lane);
        for (int e = bx * 512 + tid; e < SEQ * 32; e += G * 512) { const int pos = e >> 5, i = e & 31;
            const float inv = 1.0f / powf(10000.0f, (float)(2 * i) / 64.0f); const float ang = (float)pos * inv; float sn, cs; sincos_f(ang, sn, cs);
            ROPE[pos * 64 + i] = cs; ROPE[pos * 64 + 32 + i] = sn; }
        if (bx == 0) { for (int e = tid; e < 8 * 256; e += 512) { const int hh = e >> 8, ri = e & 255; const int rel = ri - 191; BIAS[e] = (ri < 255) ? rel_bias[t5_bucket(rel) * 8 + hh] * LOG2E : 0.f; } }
    }
    STAMP(1); xcd_barrier(bar); STAMP(2);

    for (int rep = 0; rep < (DBL_PHASE == 1 ? 2 : 1); ++rep) {
        pg8::Gemm g{H, WIN, M, 4096, DM, DM, DM}; pg8::StaticOrder S; S.init(M, 4096, G, bx);
        pg8::EpiBf<0> E{PROJ, NPROJ, SSQ, SSKV, ROPE}; pg8::gemm_phase(lds, g, S, E);
    }
    STAMP(3); xcd_barrier(bar); STAMP(4);

    for (int rep = 0; rep < (DBL_PHASE == 2 ? 2 : 1); ++rep) {
        const int cp = bx - 40;
        { pg8::Gemm g{H, WIN + (size_t)PC_KPE * DM, M, 256, DM, DM, DM}; pg8::StaticOrder S; S.init_range(M, 256, bx, 1, bx < 32 ? 1 : 0);
          pg8::EpiBf<4> E{PROJ + PC_KPE, NPROJ, SSQ, SSKV, ROPE}; pg8::gemm_phase(lds, g, S, E); }
        { pg8::Gemm g{MEMN, WMEM, MMEM, NMKV, DM, DM, DM}; pg8::StaticOrder S; S.init_range(MMEM, NMKV, bx - 32, 1, (bx >= 32 && bx < 40) ? 1 : 0);
          pg8::EpiBf<3> E{MEMKV, NMKV, nullptr, nullptr, ROPE}; pg8::gemm_phase(lds, g, S, E); }
        { pg8::Gemm g{PROJ + PC_CQ, WUQ, M, NQ, QL, NPROJ, QL}; pg8::StaticOrder S; S.init_range(M, NQ, cp, 1, (cp >= 0 && cp < 192) ? 1 : 0);
          pg8::EpiBf<1> E{Q, NQ, SSQ, SSKV, ROPE}; pg8::gemm_phase(lds, g, S, E); }
        { const int st = cp < 192 ? cp : 192 + 3 * (cp - 192);
          pg8::Gemm g{PROJ + PC_CKV, WUKV, M, NKV, KVL, NPROJ, KVL}; pg8::StaticOrder S; S.init_range(M, NKV, st, 1, cp < 0 ? 0 : (cp < 192 ? 1 : 3));
          pg8::EpiBf<2> E{KV, NKV, SSQ, SSKV, ROPE}; pg8::gemm_phase(lds, g, S, E); }
        if (cp >= 0) {
            for (int u = cp; u < 512; u += 216) {
                const int bh = u >> 5, qb = u & 31; const int b = bh >> 3, hh = bh & 7, kvh = hh >> 2;
                const size_t r0 = (size_t)b * SEQ, q0 = r0 + (size_t)qb * 128;
                const int t0 = (qb == 0) ? 0 : 2 * qb - 2, nt = (qb == 0) ? 2 : 4;
                attn::attn_unit<64, 64, 1>(lds, PROJ + q0 * NPROJ + PC_QSWA + hh * 64, NPROJ, nullptr, 0, PROJ + r0 * NPROJ + PC_KSWA + kvh * 64, NPROJ, PROJ + r0 * NPROJ + PC_VSWA + kvh * 64, NPROJ,
                    PROJ + q0 * NPROJ + PC_ZSWA + hh * 64, NPROJ, MIX + q0 * DM + 1024 + hh * 64, DM, t0, nt, 2 * qb, BIAS + hh * 256, sinks[hh] * LOG2E, qb * 128);
            }
        }
    }
    STAMP(5); xcd_barrier(bar); STAMP(6);

    for (int rep = 0; rep < (DBL_PHASE >= 3 && DBL_PHASE <= 6 ? 2 : 1); ++rep) {
        if ((PHASE_MASK & 4) && (rep == 0 || DBL_PHASE == 3 || DBL_PHASE == 4)) {
            for (int i = 0; i < 2; ++i) {
                const int p = vcu; const int bh = p >> 4, j = p & 15; const int qb = (i == 0) ? 31 - j : j; const int b = bh >> 3, hh = bh & 7;
                const size_t r0 = (size_t)b * SEQ, q0 = r0 + (size_t)qb * 128;
                attn::attn_unit<192, 128, 0>(lds, Q + q0 * NQ + hh * 192, NQ, KV + r0 * NKV + hh * 256, NKV, PROJ + r0 * NPROJ + PC_KPE, NPROJ, KV + r0 * NKV + hh * 256 + 128, NKV,
                    PROJ + q0 * NPROJ + PC_ZMLA + hh * 128, NPROJ, MIX + q0 * DM + hh * 128, DM, 0, 2 * qb + 2, 2 * qb, nullptr, 0.f, 0);
                STAMP(7 + i);
            }
        }
        if ((PHASE_MASK & 16) && (rep == 0 || DBL_PHASE == 3 || DBL_PHASE == 6)) {
            const int u = vcu; const int bh = u >> 5, qb = u & 31; const int b = bh >> 2, hh = bh & 3;
            const size_t r0 = (size_t)b * SEQ, q0 = r0 + (size_t)qb * 128; const size_t m0 = (size_t)b * NMEM;
            attn::attn_unit<128, 128, 2>(lds, PROJ + q0 * NPROJ + PC_QMEM + hh * 128, NPROJ, MEMKV + m0 * NMKV + hh * 128, NMKV, nullptr, 0, MEMKV + m0 * NMKV + 512 + hh * 128, NMKV,
                PROJ + q0 * NPROJ + PC_ZMEM + hh * 128, NPROJ, MIX + q0 * DM + 1536 + hh * 128, DM, 0, 4, 0, nullptr, 0.f, 0);
        }
        if ((PHASE_MASK & 28) != 28) {
            for (int m = gw; m < M; m += NGW) { u32x4 z = {0u, 0u, 0u, 0u};
                if (!(PHASE_MASK & 4)) { *(u32x4*)(MIX + (size_t)m * DM + lane * 8) = z; *(u32x4*)(MIX + (size_t)m * DM + 512 + lane * 8) = z; }
                if (!(PHASE_MASK & 8)) *(u32x4*)(MIX + (size_t)m * DM + 1024 + lane * 8) = z;
                if (!(PHASE_MASK & 16)) *(u32x4*)(MIX + (size_t)m * DM + 1536 + lane * 8) = z; }
        }
    }
    STAMP(11); xcd_barrier(bar); STAMP(12);

    for (int rep = 0; rep < (DBL_PHASE == 7 ? 2 : 1); ++rep) {
        pg8::Gemm g{MIX, WOUT, M, DM, DM, DM, DM}; pg8::StaticOrder S; S.init(M, DM, G, bx);
        pg8::EpiOut E{x, out, SSOUT}; pg8::gemm_phase(lds, g, S, E);
    }
    STAMP(13); xcd_barrier(bar); STAMP(14);

    {
        const bool poison = (xb_ld((unsigned*)(ctl + CW_BAR) + XB_TMO) != 0u);
        int tid5 = threadIdx.x; asm volatile("" : "+v"(tid5)); const int lane = tid5 & 63; const int gw = vcu * NWAVES + __builtin_amdgcn_readfirstlane(tid5 >> 6);
        for (int m = gw; m < M; m += NGW) {
            const GAS f32x4* gr = (const GAS f32x4*)g_fin + lane;
            if (PHASE_MASK & 32) {
                GAS f32x4* yr = (GAS f32x4*)(out + (size_t)m * DM) + lane;
                float s = (lane < 32) ? SSOUT[(size_t)m * 32 + lane] : 0.f; s = wave_sum(s);
                float rstd = 1.0f / sqrtf(s * (1.f / DM) + EPS); if (poison) rstd = __builtin_nanf("");
#pragma unroll
                for (int j = 0; j < 8; ++j) { const f32x4 v = yr[64 * j]; const f32x4 gg = gr[64 * j]; yr[64 * j] = v * rstd * gg; }
            } else {
                const GAS f32x4* xr = (const GAS f32x4*)(x + (size_t)m * DM) + lane; GAS f32x4* yr = (GAS f32x4*)(out + (size_t)m * DM) + lane;
                f32x4 v[8]; float s = 0.f;
#pragma unroll
                for (int j = 0; j < 8; ++j) { v[j] = xr[64 * j]; s += (v[j].x * v[j].x + v[j].y * v[j].y) + (v[j].z * v[j].z + v[j].w * v[j].w); }
                const float rstd = 1.0f / sqrtf(wave_sum(s) * (1.f / DM) + EPS);
#pragma unroll
                for (int j = 0; j < 8; ++j) { const f32x4 gg = gr[64 * j]; yr[64 * j] = v[j] * rstd * gg; }
            }
        }
    }
    if (TS_PROBE) {
        STAMP(15); xcd_barrier(bar);
        if (bx == 0) {
            LAS float* red = (LAS float*)lds;
            float va = 0.f, vb = 0.f;
            if (tid < 256) { va = (float)(long long)(TS[TS_A * 256 + tid] - TS[(TS_A - 1) * 256 + tid]) * 0.01f; vb = (float)(long long)(TS[TS_B * 256 + tid] - TS[(TS_B - 1) * 256 + tid]) * 0.01f; }
            red[tid] = va; red[512 + tid] = vb; __syncthreads();
            if (tid == 0) { float sa_ = 0.f, ma_ = 0.f, sb_ = 0.f, mb_ = 0.f; for (int i = 0; i < 256; ++i) { sa_ += red[i]; ma_ = fmaxf(ma_, red[i]); sb_ += red[512 + i]; mb_ = fmaxf(mb_, red[512 + i]); }
                red[1024] = (TS_MODE ? ma_ : sa_ * (1.f / 256.f)) * 0.1f; red[1025] = (TS_MODE ? mb_ : sb_ * (1.f / 256.f)) * 0.004f; }
            __syncthreads();
            if (tid == 0) out[0] += red[1024];
            for (int e = tid; e < 1024; e += 512) out[4096 + e] += red[1025];
        }
    }
}

extern "C" void kernel_launch(void* const* d_in, const int* in_sizes, int n_in, void* d_out, int out_size, void* d_ws, size_t ws_size, hipStream_t stream) {
    static int grid = 0;
    if (grid == 0) {
        if (n_in != 14 || in_sizes[0] != M * DM || out_size != M * DM || ws_size < WS_END) { fprintf(stderr, "kernel_launch: unexpected shapes (n_in %d, in0 %d, out %d, ws %zu)\n", n_in, n_in > 0 ? in_sizes[0] : -1, out_size, ws_size); grid = -1; return; }
        int dev = 0, cus = 0, per_cu = 0;
        if (hipGetDevice(&dev) != hipSuccess || hipDeviceGetAttribute(&cus, hipDeviceAttributeMultiprocessorCount, dev) != hipSuccess) { grid = -1; return; }
        if (hipFuncSetAttribute((const void*)hybrid_fwd, hipFuncAttributeMaxDynamicSharedMemorySize, LDS_BYTES) != hipSuccess) { fprintf(stderr, "kernel_launch: hipFuncSetAttribute failed\n"); grid = -1; return; }
        if (hipOccupancyMaxActiveBlocksPerMultiprocessor(&per_cu, (const void*)hybrid_fwd, NWAVES * 64, LDS_BYTES) != hipSuccess || per_cu < 1)
            fprintf(stderr, "kernel_launch: note: occupancy query reports %d workgroups per CU\n", per_cu);
        (void)hipGetLastError();
        grid = cus;
        if (grid != 256) fprintf(stderr, "kernel_launch: note: %d CUs\n", grid);
    }
    if (grid < 0) return;
    (void)hipMemsetAsync((char*)d_ws + WS_CTL, 0, CTL_ZERO_BYTES, stream);
    Args a{};
    for (int i = 0; i < 14; ++i) a.in[i] = (const float*)d_in[i];
    a.out = (float*)d_out; a.ws = (unsigned char*)d_ws;
    hipLaunchKernelGGL(hybrid_fwd, dim3(grid), dim3(NWAVES * 64), LDS_BYTES, stream, a);
}
```
